# Optimizing an MI355X kernel written in HIP

```python
import jax, jax.numpy as jnp
from jax import lax
import numpy as np

D_MODEL = 1024
BATCH = 2
SEQ = 8192
DEPTH = 1

PLE_DIM = 256
EPS = 1e-6

A_GROUPS = 8
A_WIDTH = 512
A_GROUP_DIM = A_WIDTH // A_GROUPS
A_CHUNK = 128

B_HEADS = 4
B_KEY = D_MODEL // 2
B_VAL = D_MODEL
B_HK = B_KEY // B_HEADS
B_HV = B_VAL // B_HEADS
B_GATE_RANK = 16
B_GATE_NORM = 16.0
B_CHUNK = 64

D_FF = 2816
CONV_W = 3

IN_SPLITS = (A_WIDTH, A_WIDTH, B_KEY, B_KEY, B_VAL, B_VAL, B_GATE_RANK, D_MODEL, D_MODEL)
IN_COLS = A_WIDTH * 2 + B_KEY * 2 + B_VAL * 2 + B_GATE_RANK + D_MODEL * 2

kernel_name = "hybrid_gmlp_gla_convffn_block"


def rms_norm(x, w):
    x32 = x.astype(jnp.float32)
    y = x32 * lax.rsqrt(jnp.mean(x32 * x32, axis=-1, keepdims=True) + EPS)
    return (y * w.astype(jnp.float32)).astype(x.dtype)


def layer_norm(x, g, b):
    x32 = x.astype(jnp.float32)
    mu = jnp.mean(x32, axis=-1, keepdims=True)
    var = jnp.mean(jnp.square(x32 - mu), axis=-1, keepdims=True)
    y = (x32 - mu) * lax.rsqrt(var + EPS) * g.astype(jnp.float32) + b.astype(jnp.float32)
    return y.astype(x.dtype)


def split_cols(z):
    out, off = [], 0
    for width in IN_SPLITS:
        out.append(z[..., off:off + width])
        off += width
    return out


def spatial_gating_unit(u, v, ln_g, ln_b, w_s, b_s):
    bsz, seq, _ = v.shape
    n_chunks = seq // A_CHUNK
    v = layer_norm(v, ln_g, ln_b).reshape(bsz, n_chunks, A_CHUNK, A_GROUPS, A_GROUP_DIM)
    causal = jnp.tril(jnp.ones((A_CHUNK, A_CHUNK), dtype=bool))
    w = jnp.where(causal, w_s, 0.0).astype(v.dtype)
    s = jnp.einsum('gts,bcsgd->bctgd', w, v) + b_s.T[None, None, :, :, None].astype(v.dtype)
    return u * s.reshape(bsz, seq, A_WIDTH)


def gla_chunked(q, k, v, log_a):
    bsz, nh, seq, dk = q.shape
    dv = v.shape[-1]
    nc = seq // B_CHUNK
    r = lambda t: t.reshape(bsz, nh, nc, B_CHUNK, t.shape[-1])
    q, k, v, log_a = r(q), r(k), r(v), r(log_a)
    b = jnp.cumsum(log_a, axis=3)
    b_last = b[:, :, :, -1:, :]
    q_dec = q * jnp.exp(b)
    k_inv = k * jnp.exp(-b)
    k_tail = k * jnp.exp(b_last - b)
    causal = jnp.tril(jnp.ones((B_CHUNK, B_CHUNK), dtype=bool))
    scores = jnp.where(causal, jnp.einsum('bhnid,bhnjd->bhnij', q_dec, k_inv), 0.0)
    o_intra = jnp.einsum('bhnij,bhnjv->bhniv', scores, v)
    kv = jnp.einsum('bhnjd,bhnjv->bhndv', k_tail, v)
    decay = jnp.exp(b_last[:, :, :, 0, :])

    def step(state, inp):
        q_c, kv_c, dec_c = inp
        o = jnp.einsum('bhid,bhdv->bhiv', q_c, state)
        state = state * dec_c[..., None] + kv_c
        return state, o

    init = jnp.zeros((bsz, nh, dk, dv), q.dtype)
    xs = (jnp.moveaxis(q_dec, 2, 0), jnp.moveaxis(kv, 2, 0), jnp.moveaxis(decay, 2, 0))
    _, o_inter = lax.scan(step, init, xs)
    o = o_intra + jnp.moveaxis(o_inter, 0, 2)
    return o.reshape(bsz, nh, seq, dv)


def gla_branch(q, k, v, g_out, g_lr, w_gk, b_gk, onorm_w):
    bsz, seq, _ = q.shape
    heads = lambda t, d: t.reshape(bsz, seq, B_HEADS, d).transpose(0, 2, 1, 3).astype(jnp.float32)
    log_a = jax.nn.log_sigmoid((g_lr @ w_gk + b_gk).astype(jnp.float32)) / B_GATE_NORM
    o = gla_chunked(heads(q, B_HK) * (B_HK ** -0.5), heads(k, B_HK), heads(v, B_HV), heads(log_a, B_HK))
    o = rms_norm(o.transpose(0, 2, 1, 3), onorm_w)
    return o.reshape(bsz, seq, B_VAL).astype(q.dtype) * jax.nn.silu(g_out)


def causal_depthwise_conv(x, w, b):
    seq = x.shape[1]
    xp = jnp.pad(x, ((0, 0), (CONV_W - 1, 0), (0, 0)))
    y = b
    for j in range(CONV_W):
        y = y + xp[:, j:j + seq, :] * w[j]
    return y


def setup_inputs(seed: int = 0) -> dict:
    key = jax.random.key(seed)
    ks = iter(jax.random.split(key, 32))
    f32 = jnp.float32
    nrm = lambda shape, scale: jax.random.normal(next(ks), shape, f32) * scale
    gain = lambda n: 1.0 + nrm((DEPTH, n), 0.05)
    return {
        "x": nrm((BATCH, SEQ, D_MODEL), 1.0),
        "p": nrm((DEPTH, BATCH, SEQ, PLE_DIM), 1.0),
        "pre_mix_norm": gain(D_MODEL),
        "w_in": nrm((DEPTH, D_MODEL, IN_COLS), D_MODEL ** -0.5),
        "a_ln_g": gain(A_WIDTH),
        "a_ln_b": nrm((DEPTH, A_WIDTH), 0.02),
        "a_spatial_w": nrm((DEPTH, A_GROUPS, A_CHUNK, A_CHUNK), A_CHUNK ** -0.5),
        "a_spatial_b": 1.0 + nrm((DEPTH, A_GROUPS, A_CHUNK), 0.02),
        "a_out": nrm((DEPTH, A_WIDTH, D_MODEL), A_WIDTH ** -0.5),
        "b_gk": nrm((DEPTH, B_GATE_RANK, B_KEY), B_GATE_RANK ** -0.5),
        "b_gk_bias": nrm((DEPTH, B_KEY), 0.1),
        "b_out_norm": gain(B_HV),
        "b_out": nrm((DEPTH, B_VAL, D_MODEL), B_VAL ** -0.5),
        "w_mix_out": nrm((DEPTH, D_MODEL, D_MODEL), D_MODEL ** -0.5),
        "post_mix_norm": gain(D_MODEL),
        "pre_ffn_norm": gain(D_MODEL),
        "w_up": nrm((DEPTH, D_MODEL, 2 * D_FF), D_MODEL ** -0.5),
        "conv_w": nrm((DEPTH, CONV_W, 2 * D_FF), CONV_W ** -0.5),
        "conv_b": nrm((DEPTH, 2 * D_FF), 0.02),
        "w_down": nrm((DEPTH, D_FF, D_MODEL), D_FF ** -0.5),
        "post_ffn_norm": gain(D_MODEL),
        "w_ple": nrm((DEPTH, PLE_DIM, D_MODEL), PLE_DIM ** -0.5),
        "w_ple_gate": nrm((DEPTH, D_MODEL, D_MODEL), D_MODEL ** -0.5),
        "post_ple_norm": gain(D_MODEL),
    }


def reference(x, p, pre_mix_norm, w_in, a_ln_g, a_ln_b, a_spatial_w, a_spatial_b, a_out,
              b_gk, b_gk_bias, b_out_norm, b_out, w_mix_out, post_mix_norm, pre_ffn_norm,
              w_up, conv_w, conv_b, w_down, post_ffn_norm, w_ple, w_ple_gate, post_ple_norm):
    h = x
    for i in range(DEPTH):
        a = rms_norm(h, pre_mix_norm[i])
        u_a, v_a, q_b, k_b, v_b, og_b, lr_b, gate_a, gate_b = split_cols(a @ w_in[i])
        y_a = spatial_gating_unit(jax.nn.gelu(u_a), jax.nn.gelu(v_a), a_ln_g[i], a_ln_b[i],
                                  a_spatial_w[i], a_spatial_b[i]) @ a_out[i]
        y_b = gla_branch(q_b, k_b, v_b, og_b, lr_b, b_gk[i], b_gk_bias[i], b_out_norm[i]) @ b_out[i]
        mixed = (jax.nn.sigmoid(gate_a) * y_a + jax.nn.sigmoid(gate_b) * y_b) @ w_mix_out[i]
        h = h + rms_norm(mixed, post_mix_norm[i])
        c = rms_norm(h, pre_ffn_norm[i])
        up = causal_depthwise_conv(c @ w_up[i], conv_w[i], conv_b[i])
        g_ff, v_ff = up[..., :D_FF], up[..., D_FF:]
        f = (jax.nn.gelu(g_ff, approximate=True) * v_ff) @ w_down[i]
        h = h + rms_norm(f, post_ffn_norm[i])
        ple = jax.nn.sigmoid(h @ w_ple_gate[i]) * (p[i] @ w_ple[i])
        h = h + rms_norm(ple, post_ple_norm[i])
    return h
```

```cpp
#include <hip/hip_runtime.h>
#include <cstdio>
#include <cstdint>
namespace pg8 {
#define PG8_LAS __attribute__((address_space(3)))
typedef unsigned short bf16_t;
typedef short bf16x8 __attribute__((ext_vector_type(8)));
typedef float f32x4 __attribute__((ext_vector_type(4)));
typedef unsigned u32x4 __attribute__((ext_vector_type(4)));
constexpr int BM = 256, BK = 64, HALF = 128, HTB = HALF * BK * 2  , STAGE_BYTES = 8 * HTB, NXCD = 8, WGM = 8;

__host__ __device__ __forceinline__ int lds_byte(int r, int c) { const int st = (r >> 4) * 2 + (c >> 5), rr = r & 15, cc = c & 31, ob = rr * 64 + cc * 2; return st * 1024 + (ob ^ (((ob >> 9) & 1) << 5)); }
__host__ __device__ __forceinline__ void stage_rc(int b, int& R, int& C) { const int st = b / 1024, sb = b % 1024, swz = sb ^ (((sb >> 9) & 1) << 5); R = (st >> 1) * 16 + swz / 64; C = (st & 1) * 32 + (swz % 64) / 2; }
__host__ __device__ __forceinline__ int perm32(int rho) { const int n = rho >> 4, i = rho & 15; return 8 * (i >> 2) + 4 * n + (i & 3); }

struct Unit { int pm, pn; };
struct Gemm { const bf16_t* A; const bf16_t* Bt; int M, N, K, lda; };

struct StaticOrder {
    int nM, nN, nwg, G, c;
    __host__ __device__ void init(int M, int N, int G_, int c_) { nM = M / BM; nN = N / BM; nwg = nM * nN; G = G_; c = c_; }
    __host__ __device__ bool next(int i, Unit& u) const {
        const long L = (long)i * G + c; if (L >= nwg) return false;
        int wgid = (int)L; { const int q = nwg / NXCD, r = nwg % NXCD, xcd = wgid % NXCD, off = wgid / NXCD; wgid = (xcd < r ? xcd * (q + 1) : r * (q + 1) + (xcd - r) * q) + off; }
        const int nig = WGM * nN, gid = wgid / nig, fm = gid * WGM, gsz = (nM - fm) < WGM ? (nM - fm) : WGM;
        u.pm = fm + ((wgid % nig) % gsz); u.pn = (wgid % nig) / gsz; return true;
    }
    __device__ __forceinline__ void a_ready(const Unit&) const {}
    __device__ __forceinline__ void done(const Unit&) const {}
};

__device__ __forceinline__ unsigned cvt_pk_bf16(float lo, float hi) { unsigned r; asm volatile("v_cvt_pk_bf16_f32 %0, %1, %2" : "=v"(r) : "v"(lo), "v"(hi)); return r; }
typedef float f32x2 __attribute__((ext_vector_type(2)));
template <class Epi, class Sched, bool ALIGN_EPI = false, bool SP2 = false>
__device__ __forceinline__ void gemm_phase(PG8_LAS unsigned char* lds, const Gemm g, const Sched& S, const Epi& E) {
    const int tid = threadIdx.x, wid = __builtin_amdgcn_readfirstlane(tid >> 6), lane = tid & 63, wr = wid >> 2, wc = wid & 3, fr = lane & 15, fq = lane >> 4;
    const int K = g.K, nt = K / BK;
    unsigned voffA[2], voffB[2];
#pragma unroll
    for (int i = 0; i < 2; ++i) { int R, C; stage_rc(tid * 16 + i * 8192, R, C); const int Rb = Epi::PERM ? ((R & ~31) + perm32(R & 31)) : R;
        voffA[i] = (unsigned)(R * g.lda + C) * 2u; voffB[i] = (unsigned)(Rb * K + C) * 2u; }
    const size_t kstep = (size_t)(BK * 2);
    const size_t hstepB = (size_t)HALF * K * 2, hstepA = (size_t)HALF * g.lda * 2;
    const size_t tstepA = 2 * hstepA, tstepB = 2 * hstepB;
    const unsigned ldsw = (unsigned)wid * 1024u;
    const int aoff = lds_byte(wr * 64 + fr, fq * 8), boff = lds_byte(wc * 32 + fr, fq * 8);
#define PG8_SA(b, h) (((b) * 2 + (h)) * HTB)
#define PG8_SB(b, h) ((4 + (b) * 2 + (h)) * HTB)
#define PG8_STAGE(bufoff, gbase, voff) do { _Pragma("unroll") for (int _i = 0; _i < 2; ++_i) \
        __builtin_amdgcn_global_load_lds((const unsigned*)((const char*)(gbase) + (voff)[_i]), (PG8_LAS unsigned*)(lds + (bufoff) + ldsw + _i * 8192), 16, 0, 0); } while (0)
#define PG8_LDA(dst, b, h) do { _Pragma("unroll") for (int m = 0; m < 4; ++m) _Pragma("unroll") for (int k = 0; k < 2; ++k) dst[m][k] = *(const PG8_LAS bf16x8*)(lds + PG8_SA(b, h) + aoff + m * 2048 + k * 1024); } while (0)
#define PG8_LDB(dst, b, h) do { _Pragma("unroll") for (int n = 0; n < 2; ++n) _Pragma("unroll") for (int k = 0; k < 2; ++k) dst[n][k] = *(const PG8_LAS bf16x8*)(lds + PG8_SB(b, h) + boff + n * 2048 + k * 1024); } while (0)
#define PG8_MMA(ai, bj, At, Bt) do { __builtin_amdgcn_s_setprio(1); _Pragma("unroll") for (int m = 0; m < 4; ++m) _Pragma("unroll") for (int n = 0; n < 2; ++n) _Pragma("unroll") for (int k = 0; k < 2; ++k) \
        acc[ai][bj][m][n] = __builtin_amdgcn_mfma_f32_16x16x32_bf16(Bt[n][k], At[m][k], acc[ai][bj][m][n], 0, 0, 0); __builtin_amdgcn_s_setprio(0); } while (0)
#define PG8_WAIT_V(n) asm volatile("s_waitcnt vmcnt(" #n ")" ::: "memory")
#define PG8_WAIT_L(n) asm volatile("s_waitcnt lgkmcnt(" #n ")" ::: "memory")
#define PG8_BAR __builtin_amdgcn_s_barrier()
#define PG8_SCHED __builtin_amdgcn_sched_barrier(0)
    Unit cur, nxt; int ui = 0;
    if (!S.next(0, cur)) return;
    f32x4 acc[2][2][4][2];
#pragma unroll
    for (int a = 0; a < 2; ++a)
#pragma unroll
        for (int b = 0; b < 2; ++b)
#pragma unroll
            for (int m = 0; m < 4; ++m)
#pragma unroll
                for (int n = 0; n < 2; ++n) acc[a][b][m][n] = (f32x4){0.f, 0.f, 0.f, 0.f};
    bf16x8 At[4][2], B0[2][2], B1[2][2];
    const char* cA = (const char*)g.A + (size_t)cur.pm * tstepA; const char* cB = (const char*)g.Bt + (size_t)cur.pn * tstepB;
    S.a_ready(cur);
    if constexpr (SP2) {
        PG8_STAGE(PG8_SB(0, 0), cB, voffB); PG8_STAGE(PG8_SB(0, 1), cB + hstepB, voffB); PG8_STAGE(PG8_SA(0, 0), cA, voffA); PG8_STAGE(PG8_SA(0, 1), cA + hstepA, voffA);
        if (wr == 1) PG8_BAR;
        PG8_WAIT_V(2); PG8_BAR;
        PG8_STAGE(PG8_SB(1, 0), cB + kstep, voffB); PG8_STAGE(PG8_SA(1, 0), cA + kstep, voffA); PG8_STAGE(PG8_SB(1, 1), cB + hstepB + kstep, voffB);
        PG8_WAIT_V(6); PG8_BAR;
    } else {
        PG8_STAGE(PG8_SB(0, 0), cB, voffB); PG8_STAGE(PG8_SA(0, 0), cA, voffA); PG8_STAGE(PG8_SB(0, 1), cB + hstepB, voffB); PG8_STAGE(PG8_SA(0, 1), cA + hstepA, voffA);
        if (wr == 1) PG8_BAR;
        PG8_WAIT_V(4); PG8_BAR;
        PG8_STAGE(PG8_SB(1, 0), cB + kstep, voffB); PG8_STAGE(PG8_SA(1, 0), cA + kstep, voffA); PG8_STAGE(PG8_SB(1, 1), cB + hstepB + kstep, voffB);
        PG8_WAIT_V(6); PG8_BAR;
    }
    for (;;) {
        const bool has_next = S.next(ui + 1, nxt);
        const char* nA = has_next ? (const char*)g.A + (size_t)nxt.pm * tstepA : cA; const char* nB = has_next ? (const char*)g.Bt + (size_t)nxt.pn * tstepB : cB;
        for (int t = 0; t < nt; t += 2) {
            const bool last = (t == nt - 2);
            const char* a1 = cA + (size_t)(t + 1) * kstep;
            const char* a2 = last ? nA : cA + (size_t)(t + 2) * kstep; const char* b2 = last ? nB : cB + (size_t)(t + 2) * kstep;
            const char* a3 = a2 + kstep; const char* b3 = b2 + kstep;
            if (last && has_next) S.a_ready(nxt);
            if constexpr (SP2) {
            PG8_LDB(B0, 0, 0); PG8_LDB(B1, 0, 1); PG8_SCHED; PG8_LDA(At, 0, 0); PG8_STAGE(PG8_SA(1, 1), a1 + hstepA, voffA);
            PG8_WAIT_V(8); PG8_WAIT_L(0); PG8_BAR; PG8_MMA(0, 0, At, B0); PG8_MMA(0, 1, At, B1); PG8_BAR; PG8_SCHED;
            PG8_LDA(At, 0, 1); PG8_STAGE(PG8_SB(0, 0), b2, voffB); PG8_STAGE(PG8_SB(0, 1), b2 + hstepB, voffB); PG8_STAGE(PG8_SA(0, 0), a2, voffA);
            PG8_WAIT_V(8); PG8_WAIT_L(0); PG8_BAR; PG8_MMA(1, 0, At, B0); PG8_MMA(1, 1, At, B1); PG8_BAR; PG8_SCHED;
            PG8_LDB(B0, 1, 0); PG8_LDB(B1, 1, 1); PG8_SCHED; PG8_LDA(At, 1, 0); PG8_STAGE(PG8_SA(0, 1), a2 + hstepA, voffA);
            PG8_WAIT_V(8); PG8_WAIT_L(0); PG8_BAR; PG8_MMA(0, 0, At, B0); PG8_MMA(0, 1, At, B1); PG8_BAR; PG8_SCHED;
            PG8_LDA(At, 1, 1); PG8_STAGE(PG8_SB(1, 0), b3, voffB); PG8_STAGE(PG8_SB(1, 1), b3 + hstepB, voffB); PG8_STAGE(PG8_SA(1, 0), a3, voffA);
            PG8_WAIT_V(8); PG8_WAIT_L(0); PG8_BAR; PG8_MMA(1, 0, At, B0); PG8_MMA(1, 1, At, B1); PG8_BAR; PG8_SCHED;
            } else {
            PG8_LDB(B0, 0, 0); PG8_SCHED; PG8_LDA(At, 0, 0); PG8_STAGE(PG8_SA(1, 1), a1 + hstepA, voffA);
            PG8_WAIT_L(8); PG8_BAR; PG8_WAIT_L(0); PG8_MMA(0, 0, At, B0); PG8_BAR; PG8_SCHED;
            PG8_LDB(B1, 0, 1); PG8_STAGE(PG8_SB(0, 0), b2, voffB);
            PG8_BAR; PG8_WAIT_L(0); PG8_MMA(0, 1, At, B1); PG8_BAR;
            PG8_LDA(At, 0, 1); PG8_STAGE(PG8_SA(0, 0), a2, voffA);
            PG8_BAR; PG8_WAIT_L(0); PG8_MMA(1, 0, At, B0); PG8_BAR; PG8_SCHED;
            PG8_STAGE(PG8_SB(0, 1), b2 + hstepB, voffB);
            PG8_WAIT_V(6); PG8_BAR; PG8_MMA(1, 1, At, B1); PG8_BAR;
            PG8_LDB(B0, 1, 0); PG8_SCHED; PG8_LDA(At, 1, 0); PG8_STAGE(PG8_SA(0, 1), a2 + hstepA, voffA);
            PG8_WAIT_L(8); PG8_BAR; PG8_WAIT_L(0); PG8_MMA(0, 0, At, B0); PG8_BAR; PG8_SCHED;
            PG8_LDB(B1, 1, 1); PG8_STAGE(PG8_SB(1, 0), b3, voffB);
            PG8_BAR; PG8_WAIT_L(0); PG8_MMA(0, 1, At, B1); PG8_BAR;
            PG8_LDA(At, 1, 1); PG8_STAGE(PG8_SA(1, 0), a3, voffA);
            PG8_BAR; PG8_WAIT_L(0); PG8_MMA(1, 0, At, B0); PG8_BAR; PG8_SCHED;
            PG8_STAGE(PG8_SB(1, 1), b3 + hstepB, voffB);
            PG8_WAIT_V(6); PG8_BAR; PG8_MMA(1, 1, At, B1); PG8_BAR;
            }
        }
        if constexpr (ALIGN_EPI) { if (wr == 0) PG8_BAR; }
        if constexpr (!Epi::AFTER_DRAIN) { E(acc, cur, wr, wc, fr, fq); S.done(cur); }
        if (!has_next) break;
#pragma unroll
        for (int a = 0; a < 2; ++a)
#pragma unroll
            for (int b = 0; b < 2; ++b)
#pragma unroll
                for (int m = 0; m < 4; ++m)
#pragma unroll
                    for (int n = 0; n < 2; ++n) acc[a][b][m][n] = (f32x4){0.f, 0.f, 0.f, 0.f};
        cur = nxt; cA = nA; cB = nB; ++ui;
        if constexpr (ALIGN_EPI) { if (wr == 1) PG8_BAR; }
    }
    PG8_WAIT_V(0);
    if constexpr (!ALIGN_EPI) { if (wr == 0) PG8_BAR; }
    PG8_BAR;
    if constexpr (Epi::AFTER_DRAIN) { E.fused(acc, cur, wr, wc, fr, fq, lds, wid, lane); S.done(cur); }
#undef PG8_SA
#undef PG8_SB
#undef PG8_STAGE
#undef PG8_LDA
#undef PG8_LDB
#undef PG8_MMA
#undef PG8_WAIT_V
#undef PG8_WAIT_L
#undef PG8_BAR
#undef PG8_SCHED
}
}
namespace pg8 {
__device__ __forceinline__ float sigm(float t) { return __builtin_amdgcn_rcpf(1.0f + __builtin_amdgcn_exp2f(-1.44269504f * t)); }
__device__ __forceinline__ float gelu_t(float x) { const float t = x * (1.5957691216f + 0.0713548163f * x * x); return x * sigm(t); }
struct EpiPlain {
    static constexpr bool PERM = true, AFTER_DRAIN = false;
    bf16_t* O; int ldc;
    __device__ __forceinline__ void operator()(const f32x4 (&acc)[2][2][4][2], const Unit& u, int wr, int wc, int fr, int fq) const {
        const int row0 = u.pm * BM + wr * 64 + fr, col0 = u.pn * BM + wc * 32 + 8 * fq;
#pragma unroll
        for (int ai = 0; ai < 2; ++ai)
#pragma unroll
            for (int m = 0; m < 4; ++m) { bf16_t* rowp = O + (size_t)(row0 + ai * HALF + m * 16) * ldc + col0;
#pragma unroll
                for (int bj = 0; bj < 2; ++bj) { const f32x4 v0 = acc[ai][bj][m][0], v1 = acc[ai][bj][m][1];
                    u32x4 w; w.x = cvt_pk_bf16(v0[0], v0[1]); w.y = cvt_pk_bf16(v0[2], v0[3]); w.z = cvt_pk_bf16(v1[0], v1[1]); w.w = cvt_pk_bf16(v1[2], v1[3]);
                    *(u32x4*)(rowp + bj * HALF) = w; } }
    }
};
struct EpiInProj {
    static constexpr bool PERM = true, AFTER_DRAIN = false;
    bf16_t *U, *VA, *Q, *K, *VB, *OG, *GA, *GB;
    __device__ __forceinline__ void operator()(const f32x4 (&acc)[2][2][4][2], const Unit& u, int wr, int wc, int fr, int fq) const {
        const int pn = u.pn; bf16_t* base; int ldc, colt, mode;
        if (pn < 2) { base = U; ldc = 512; colt = pn * 256; mode = 2; }
        else if (pn < 4) { base = VA; ldc = 512; colt = (pn - 2) * 256; mode = 2; }
        else if (pn < 6) { base = Q; ldc = 512; colt = (pn - 4) * 256; mode = 1; }
        else if (pn < 8) { base = K; ldc = 512; colt = (pn - 6) * 256; mode = 0; }
        else if (pn < 12) { base = VB; ldc = 1024; colt = (pn - 8) * 256; mode = 0; }
        else if (pn < 16) { base = OG; ldc = 1024; colt = (pn - 12) * 256; mode = 3; }
        else if (pn < 20) { base = GA; ldc = 1024; colt = (pn - 16) * 256; mode = 4; }
        else { base = GB; ldc = 1024; colt = (pn - 20) * 256; mode = 4; }
        const int row0 = u.pm * BM + wr * 64 + fr, col0 = colt + wc * 32 + 8 * fq;
        const float sc = (mode == 1) ? 0.08838834764831845f : 1.0f;
#pragma unroll
        for (int ai = 0; ai < 2; ++ai)
#pragma unroll
            for (int m = 0; m < 4; ++m) { bf16_t* rowp = base + (size_t)(row0 + ai * HALF + m * 16) * ldc + col0;
#pragma unroll
                for (int bj = 0; bj < 2; ++bj) { float v[8];
#pragma unroll
                    for (int e = 0; e < 4; ++e) { v[e] = acc[ai][bj][m][0][e]; v[4 + e] = acc[ai][bj][m][1][e]; }
                    if (mode <= 1) {
#pragma unroll
                        for (int e = 0; e < 8; ++e) v[e] *= sc;
                    } else if (mode == 2) {
#pragma unroll
                        for (int e = 0; e < 8; ++e) v[e] = gelu_t(v[e]);
                    } else if (mode == 3) {
#pragma unroll
                        for (int e = 0; e < 8; ++e) v[e] = v[e] * sigm(v[e]);
                    } else {
#pragma unroll
                        for (int e = 0; e < 8; ++e) v[e] = sigm(v[e]);
                    }
                    u32x4 w; w.x = cvt_pk_bf16(v[0], v[1]); w.y = cvt_pk_bf16(v[2], v[3]); w.z = cvt_pk_bf16(v[4], v[5]); w.w = cvt_pk_bf16(v[6], v[7]);
                    *(u32x4*)(rowp + bj * HALF) = w; } }
    }
};
struct EpiF32 {
    static constexpr bool PERM = false, AFTER_DRAIN = false;
    float* C; int ldc;
    __device__ __forceinline__ void operator()(const f32x4 (&acc)[2][2][4][2], const Unit& u, int wr, int wc, int fr, int fq) const {
        const int row0 = u.pm * BM + wr * 64 + fr, col0 = u.pn * BM + wc * 32 + 4 * fq;
#pragma unroll
        for (int ai = 0; ai < 2; ++ai)
#pragma unroll
            for (int m = 0; m < 4; ++m) { float* rowp = C + (size_t)(row0 + ai * HALF + m * 16) * ldc + col0;
#pragma unroll
                for (int bj = 0; bj < 2; ++bj)
#pragma unroll
                    for (int n = 0; n < 2; ++n) *(f32x4*)(rowp + bj * HALF + n * 16) = acc[ai][bj][m][n]; }
    }
};
__device__ __forceinline__ float bfx(unsigned w, int hi) { return __uint_as_float(hi ? (w & 0xffff0000u) : (w << 16)); }
struct EpiGateMul {
    static constexpr bool PERM = false, AFTER_DRAIN = false;
    const bf16_t* G; float* T; int ldc;
    __device__ __forceinline__ void operator()(const f32x4 (&acc)[2][2][4][2], const Unit& u, int wr, int wc, int fr, int fq) const {
        const int row0 = u.pm * BM + wr * 64 + fr, col0 = u.pn * BM + wc * 32 + 4 * fq;
#pragma unroll
        for (int ai = 0; ai < 2; ++ai)
#pragma unroll
            for (int m = 0; m < 4; ++m) { const size_t off = (size_t)(row0 + ai * HALF + m * 16) * ldc + col0;
#pragma unroll
                for (int bj = 0; bj < 2; ++bj)
#pragma unroll
                    for (int n = 0; n < 2; ++n) { const uint2 g = *(const uint2*)(G + off + bj * HALF + n * 16); const f32x4 a = acc[ai][bj][m][n];
                        f32x4 o; o[0] = a[0] * bfx(g.x, 0); o[1] = a[1] * bfx(g.x, 1); o[2] = a[2] * bfx(g.y, 0); o[3] = a[3] * bfx(g.y, 1);
                        *(f32x4*)(T + off + bj * HALF + n * 16) = o; } }
    }
};
struct EpiGateMulAdd {
    static constexpr bool PERM = false, AFTER_DRAIN = false;
    const bf16_t* G; const float* T; bf16_t* O; int ldc;
    __device__ __forceinline__ void operator()(const f32x4 (&acc)[2][2][4][2], const Unit& u, int wr, int wc, int fr, int fq) const {
        const int row0 = u.pm * BM + wr * 64 + fr, col0 = u.pn * BM + wc * 32 + 4 * fq;
#pragma unroll
        for (int ai = 0; ai < 2; ++ai)
#pragma unroll
            for (int m = 0; m < 4; ++m) { const size_t off = (size_t)(row0 + ai * HALF + m * 16) * ldc + col0;
#pragma unroll
                for (int bj = 0; bj < 2; ++bj)
#pragma unroll
                    for (int n = 0; n < 2; ++n) { const uint2 g = *(const uint2*)(G + off + bj * HALF + n * 16); const f32x4 a = acc[ai][bj][m][n]; const f32x4 t = *(const f32x4*)(T + off + bj * HALF + n * 16);
                        uint2 o; o.x = cvt_pk_bf16(t[0] + a[0] * bfx(g.x, 0), t[1] + a[1] * bfx(g.x, 1)); o.y = cvt_pk_bf16(t[2] + a[2] * bfx(g.y, 0), t[3] + a[3] * bfx(g.y, 1));
                        *(uint2*)(O + off + bj * HALF + n * 16) = o; } }
    }
};
}
#define GAS __attribute__((address_space(1)))
#define LAS __attribute__((address_space(3)))
typedef unsigned short bf16;
typedef unsigned v4u __attribute__((ext_vector_type(4)));
typedef float f32x4 __attribute__((ext_vector_type(4)));
typedef short bf16x8 __attribute__((ext_vector_type(8)));
typedef GAS unsigned gu32;
typedef GAS unsigned long long gu64;
#define RLX_AGENT __ATOMIC_RELAXED, __HIP_MEMORY_SCOPE_AGENT
#define LDS_WAIT() asm volatile("s_waitcnt lgkmcnt(0)" ::: "memory")
#define VM_WAIT() asm volatile("s_waitcnt vmcnt(0)" ::: "memory")
__device__ __forceinline__ unsigned long long rt() { return __builtin_amdgcn_s_memrealtime(); }
__device__ __forceinline__ unsigned f2bf(float f) { unsigned u = __builtin_bit_cast(unsigned, f); return (u + 0x7fffu + ((u >> 16) & 1u)) >> 16; }
__device__ __forceinline__ unsigned pk2(float lo, float hi) { return f2bf(lo) | (f2bf(hi) << 16); }

#define XB_TMO      128
#define XB_XCNT(j)  (256  + 64 * (j))
#define XB_XSUB(j)  (1280 + 64 * (j))
#define XB_XGEN(j)  (2304 + 64 * (j))
#define XB_TOP      3328
#define XB_TOPGEN   3392
#define XCD_BAR_WORDS 3456
#define XB_SPIN_CAP (1u << 18)

__device__ __forceinline__ unsigned xb_ld(unsigned* p)              { return __hip_atomic_load(p, __ATOMIC_RELAXED, __HIP_MEMORY_SCOPE_AGENT); }
__device__ __forceinline__ unsigned xb_add(unsigned* p, unsigned v) { return __hip_atomic_fetch_add(p, v, __ATOMIC_RELAXED, __HIP_MEMORY_SCOPE_AGENT); }
__device__ __forceinline__ unsigned xb_xcc_id() { return (unsigned)__builtin_amdgcn_s_getreg((3 << 11) | 20) & 0xFu; }
#define XB_SPIN(cond, bar) do { unsigned _sp = 0; while (cond) { __builtin_amdgcn_s_sleep(1); \
    if ((++_sp & 255u) == 0u) { if (xb_ld(&(bar)[XB_TMO])) break; if (_sp > XB_SPIN_CAP) { atomicAdd(&(bar)[XB_TMO], 1u); break; } } } } while (0)

struct XcdBarrier {
    unsigned* bar; unsigned x;
    volatile LAS unsigned* st;
};

__device__ __forceinline__ XcdBarrier xcd_barrier_post(unsigned* bar, volatile LAS unsigned* st) {
    XcdBarrier b; b.bar = bar; b.x = xb_xcc_id(); b.st = st;
    if (threadIdx.x == 0) (void)xb_add(&bar[XB_XCNT(b.x)], 1u);
    return b;
}
__device__ __forceinline__ void xcd_barrier_complete(unsigned* bar, unsigned x, unsigned& nloc, unsigned& nx) {
    const unsigned G = gridDim.x * gridDim.y * gridDim.z;
    unsigned sum, cnt, mine, sp = 0u;
    for (;;) {
        sum = 0u; cnt = 0u; mine = 0u;
#pragma unroll
        for (unsigned j = 0; j < 16; ++j) { const unsigned c = xb_ld(&bar[XB_XCNT(j)]); sum += c; cnt += (c > 0u) ? 1u : 0u; mine = (j == x) ? c : mine; }
        if (sum == G) break;
        __builtin_amdgcn_s_sleep(1);
        if ((++sp & 255u) == 0u) { if (xb_ld(&bar[XB_TMO])) break; if (sp > XB_SPIN_CAP) { atomicAdd(&bar[XB_TMO], 1u); break; } }
    }
    nloc = mine > 0u ? mine : 1u; nx = cnt > 0u ? cnt : 1u;
}

__device__ __forceinline__ void xcd_barrier(const XcdBarrier& b) {
    asm volatile("s_waitcnt vmcnt(0)" ::: "memory");
    __syncthreads();
    if (threadIdx.x == 0) {
        unsigned* bar = b.bar;
        __builtin_amdgcn_s_waitcnt(0);
        unsigned nloc = b.st[0], nx = b.st[1];
        if (nloc == 0u) { xcd_barrier_complete(bar, b.x, nloc, nx); b.st[0] = nloc; b.st[1] = nx; }
        const unsigned old = xb_add(&bar[XB_XSUB(b.x)], 1u);
        const unsigned gen = old / nloc;
        if (old + 1u == (gen + 1u) * nloc) {
            __builtin_amdgcn_fence(__ATOMIC_RELEASE, "agent");
            asm volatile("s_waitcnt vmcnt(0)" ::: "memory");
            const unsigned og = xb_add(&bar[XB_TOP], 1u);
            const unsigned tg = og / nx;
            if (og + 1u == (tg + 1u) * nx) xb_add(&bar[XB_TOPGEN], 1u);
            else XB_SPIN(xb_ld(&bar[XB_TOPGEN]) == tg, bar);
            __builtin_amdgcn_fence(__ATOMIC_ACQUIRE, "agent");
            xb_add(&bar[XB_XGEN(b.x)], 1u);
            asm volatile("s_waitcnt vmcnt(0)" ::: "memory");
        } else {
            XB_SPIN(xb_ld(&bar[XB_XGEN(b.x)]) == gen, bar);
            __builtin_amdgcn_fence(__ATOMIC_ACQUIRE, "agent");
            asm volatile("s_waitcnt vmcnt(0)" ::: "memory");
        }
    }
    __syncthreads();
}
constexpr int NWAVES = 8, NTHR = NWAVES * 64;
constexpr int BATCH = 2, SEQ = 8192, D = 1024, M = BATCH * SEQ;
constexpr int INCOLS = 6160, NINP = 6144, AW = 512, BKEY = 512, BVAL = 1024, DFF = 2816, NUP = 5632, PLED = 256, NHALF = 2816;
constexpr float EPS = 1e-6f;
constexpr size_t MiB = 1u << 20;
constexpr size_t WS_CTL = 0, CTL_ZERO_BYTES = 128 * 1024;
constexpr size_t WS_LR = 1 * MiB;
constexpr size_t WS_WIN = 2 * MiB, WS_AOUT = 14 * MiB, WS_BOUT = 15 * MiB, WS_WMIX = 17 * MiB, WS_WUP = 19 * MiB, WS_WDOWN = 30 * MiB, WS_WPLEG = 36 * MiB, WS_WPLE = 38 * MiB + 512 * 1024 - 512 * 1024;
constexpr size_t WS_PB = 39 * MiB;
constexpr size_t WS_U = 48 * MiB, WS_VA = 64 * MiB, WS_Q = 80 * MiB, WS_K = 96 * MiB, WS_VB = 112 * MiB, WS_OG = 144 * MiB, WS_GA = 176 * MiB, WS_GB = 208 * MiB;
constexpr size_t WS_MB = 80 * MiB;
constexpr size_t WS_C = 48 * MiB;
constexpr size_t WS_MIXED = 144 * MiB;
constexpr size_t WS_RAW = 80 * MiB, WS_ACT = 168 * MiB;
constexpr size_t WS_FB = 48 * MiB;
constexpr size_t WS_H2B = 80 * MiB;
constexpr size_t WS_GS = 112 * MiB, WS_PV = 176 * MiB;
constexpr size_t WS_END = 256 * MiB;
static_assert(WS_WPLE + (size_t)D * PLED * 2 <= WS_PB && WS_PB + (size_t)M * PLED * 2 <= WS_U && WS_GB + (size_t)M * 1024 * 2 <= WS_END && WS_ACT + (size_t)M * DFF * 2 <= WS_END && WS_RAW + (size_t)M * NHALF * 2 <= WS_ACT, "ws map");
constexpr int CW_TMO = 0, CW_CODE = 1, CW_BAR = 4096;
constexpr int RING_OFF = 0, RING_BYTES = 131072, LDSCTL_OFF = RING_BYTES, MISC_OFF = LDSCTL_OFF + 320, LDS_BYTES = 147456;

__device__ __forceinline__ float wave_sum(float v) {
#pragma unroll
    for (int o = 1; o < 64; o <<= 1) v += __shfl_xor(v, o);
    return v;
}
__device__ __forceinline__ float bf2f(unsigned short h) { return __uint_as_float((unsigned)h << 16); }
__device__ __forceinline__ float bflo(unsigned w) { return __uint_as_float(w << 16); }
__device__ __forceinline__ float bfhi(unsigned w) { return __uint_as_float(w & 0xffff0000u); }
__device__ __forceinline__ float sigm(float t) { return 1.0f / (1.0f + __expf(-t)); }
__device__ __forceinline__ float gelu_t(float x) { const float t = x * (1.5957691216f + 0.0713548163f * x * x); return x * sigm(t); }

struct Args { const float* in[24]; float* out; unsigned char* ws; int ph_lo, ph_hi, li, pad; };

__device__ __forceinline__ void p0_transpose_item(const float* W, int pitch, int src_col0, int K, bf16* WT, int dest_row0, LAS float* scr, int kb, int lane) {
    const int k0 = 64 * kb;
#pragma unroll 8
    for (int i = 0; i < 32; ++i) { const int kk = 2 * i + (lane >> 5); scr[kk * 33 + (lane & 31)] = W[(size_t)(k0 + kk) * pitch + src_col0 + (lane & 31)]; }
    LDS_WAIT(); asm volatile("" ::: "memory");
    const int c = lane & 7;
#pragma unroll
    for (int j = 0; j < 4; ++j) { const int n = (lane >> 3) + 8 * j; const LAS float* s = scr + (8 * c) * 33 + n;
        v4u o; o.x = pk2(s[0 * 33], s[1 * 33]); o.y = pk2(s[2 * 33], s[3 * 33]); o.z = pk2(s[4 * 33], s[5 * 33]); o.w = pk2(s[6 * 33], s[7 * 33]);
        *(GAS v4u*)(WT + (size_t)(dest_row0 + n) * K + k0 + 8 * c) = o; }
    LDS_WAIT(); asm volatile("" ::: "memory");
}

constexpr int NPHASES = 15;
#ifndef MK_N_LAUNCHES
#define MK_N_LAUNCHES 1
#endif
constexpr int N_LAUNCHES = MK_N_LAUNCHES;

__global__ void __launch_bounds__(NTHR, 2) fwd_kernel(Args args) {
    extern __shared__ __attribute__((aligned(16))) unsigned char lds[];
    LAS unsigned char* L = (LAS unsigned char*)lds;
    volatile LAS unsigned* MISC = (volatile LAS unsigned*)(L + MISC_OFF);
    const int tid = threadIdx.x, lane = tid & 63, wave = __builtin_amdgcn_readfirstlane(tid >> 6);
    const int G = gridDim.x, bx = blockIdx.x;
    const int vcu = (G % 8 == 0) ? (bx % 8) * (G / 8) + bx / 8 : bx;
    const int gw = vcu * NWAVES + wave, NGW = G * NWAVES;
    unsigned char* ws = args.ws;
    gu32* ctl = (gu32*)(ws + WS_CTL);
    const float* x = args.in[0]; const float* pin = args.in[1]; const float* pre_mix_norm = args.in[2]; const float* w_in = args.in[3];
    const float* a_ln_g = args.in[4]; const float* a_ln_b = args.in[5]; const float* a_sw = args.in[6]; const float* a_sb = args.in[7]; const float* a_out = args.in[8];
    const float* b_gk = args.in[9]; const float* b_gkb = args.in[10]; const float* b_onorm = args.in[11]; const float* b_out = args.in[12]; const float* w_mix = args.in[13];
    const float* post_mix_norm = args.in[14]; const float* pre_ffn_norm = args.in[15]; const float* w_up = args.in[16]; const float* conv_w = args.in[17]; const float* conv_b = args.in[18];
    const float* w_down = args.in[19]; const float* post_ffn_norm = args.in[20]; const float* w_ple = args.in[21]; const float* w_pleg = args.in[22]; const float* post_ple_norm = args.in[23];
    float* out = args.out;
    bf16* Win_t = (bf16*)(ws + WS_WIN); bf16* Aout_t = (bf16*)(ws + WS_AOUT); bf16* Bout_t = (bf16*)(ws + WS_BOUT); bf16* Wmix_t = (bf16*)(ws + WS_WMIX);
    bf16* Wup_t = (bf16*)(ws + WS_WUP); bf16* Wdown_t = (bf16*)(ws + WS_WDOWN); bf16* Wpleg_t = (bf16*)(ws + WS_WPLEG); bf16* Wple_t = (bf16*)(ws + WS_WPLE);
    float* LR = (float*)(ws + WS_LR); bf16* PB = (bf16*)(ws + WS_PB);
    bf16* Ab = (bf16*)out;
    bf16* U = (bf16*)(ws + WS_U); bf16* VA = (bf16*)(ws + WS_VA); bf16* Qb = (bf16*)(ws + WS_Q); bf16* Kb = (bf16*)(ws + WS_K); bf16* VB = (bf16*)(ws + WS_VB);
    bf16* OG = (bf16*)(ws + WS_OG); bf16* GA = (bf16*)(ws + WS_GA); bf16* GB = (bf16*)(ws + WS_GB);
    float* Of = out;
    float* Tf = out;
    bf16* MB = (bf16*)(ws + WS_MB); bf16* Cb = (bf16*)(ws + WS_C); float* MIXED = (float*)(ws + WS_MIXED);
    bf16* RAW = (bf16*)(ws + WS_RAW); bf16* ACT = (bf16*)(ws + WS_ACT); bf16* FB = (bf16*)(ws + WS_FB); bf16* H2B = (bf16*)(ws + WS_H2B);
    float* GS = (float*)(ws + WS_GS); float* PV = (float*)(ws + WS_PV);

    for (int u = tid; u < (LDS_BYTES - LDSCTL_OFF) / 4; u += NTHR) ((LAS unsigned*)(L + LDSCTL_OFF))[u] = 0u;
    __syncthreads();
    XcdBarrier bar; bar.bar = (unsigned*)(ctl + CW_BAR); bar.x = 0; bar.st = nullptr;
    if (N_LAUNCHES == 1) bar = xcd_barrier_post((unsigned*)(ctl + CW_BAR), MISC + 8);
    const int lo = args.ph_lo, hi = args.ph_hi;
#define IN(k) (lo <= (k) && (k) < hi)
#define SEAM(k) do { if (IN(k) && IN((k) + 1)) xcd_barrier(bar); } while (0)

    if (IN(0)) {
        LAS float* scr = (LAS float*)(L + RING_OFF + wave * 16384);
        constexpr int I_IN1 = 16 * 128, I_IN2 = 16 * 64, I_AO = 8 * 32, I_SQ = 16 * 32, I_UP = 16 * 176, I_DN = 44 * 32, I_PL = 4 * 32;
        constexpr int NITEMS = I_IN1 + I_IN2 + I_AO + 3 * I_SQ + I_UP + I_DN + I_PL;
        for (int it = gw; it < NITEMS; it += NGW) {
            int r = it;
            if (r < I_IN1) { const int kb = r / 128, nb = r % 128; p0_transpose_item(w_in, INCOLS, 32 * nb, D, Win_t, 32 * nb, scr, kb, lane); continue; } r -= I_IN1;
            if (r < I_IN2) { const int kb = r / 64, nb = r % 64; p0_transpose_item(w_in, INCOLS, 4112 + 32 * nb, D, Win_t, 4096 + 32 * nb, scr, kb, lane); continue; } r -= I_IN2;
            if (r < I_AO) { const int kb = r / 32, nb = r % 32; p0_transpose_item(a_out, D, 32 * nb, AW, Aout_t, 32 * nb, scr, kb, lane); continue; } r -= I_AO;
            if (r < I_SQ) { const int kb = r / 32, nb = r % 32; p0_transpose_item(b_out, D, 32 * nb, D, Bout_t, 32 * nb, scr, kb, lane); continue; } r -= I_SQ;
            if (r < I_SQ) { const int kb = r / 32, nb = r % 32; p0_transpose_item(w_mix, D, 32 * nb, D, Wmix_t, 32 * nb, scr, kb, lane); continue; } r -= I_SQ;
            if (r < I_SQ) { const int kb = r / 32, nb = r % 32; p0_transpose_item(w_pleg, D, 32 * nb, D, Wpleg_t, 32 * nb, scr, kb, lane); continue; } r -= I_SQ;
            if (r < I_UP) { const int kb = r / 176, nb = r % 176; const int n0 = 32 * nb, j = n0 >> 8, rr = n0 & 255; const int src = (rr < 128) ? (128 * j + rr) : (DFF + 128 * j + (rr - 128));
                p0_transpose_item(w_up, NUP, src, D, Wup_t, n0, scr, kb, lane); continue; } r -= I_UP;
            if (r < I_DN) { const int kb = r / 32, nb = r % 32; p0_transpose_item(w_down, D, 32 * nb, DFF, Wdown_t, 32 * nb, scr, kb, lane); continue; } r -= I_DN;
            { const int kb = r / 32, nb = r % 32; p0_transpose_item(w_ple, D, 32 * nb, PLED, Wple_t, 32 * nb, scr, kb, lane); }
        }
        const size_t NGT = (size_t)G * NTHR;
        for (size_t i = (size_t)vcu * NTHR + tid; i < (size_t)M * PLED / 8; i += NGT) { const f32x4 a = ((const f32x4*)pin)[2 * i], b = ((const f32x4*)pin)[2 * i + 1];
            v4u o; o.x = pk2(a.x, a.y); o.y = pk2(a.z, a.w); o.z = pk2(b.x, b.y); o.w = pk2(b.z, b.w); ((v4u*)PB)[i] = o; }
        __syncthreads();
        LAS float* wl = (LAS float*)(L + RING_OFF);
        for (int idx = tid; idx < 1024 * 16; idx += NTHR) { const int i = idx >> 4, c = idx & 15; wl[c * 1024 + i] = w_in[(size_t)i * INCOLS + 4096 + c]; }
        __syncthreads();
        for (int m = gw; m < M; m += NGW) {
            asm volatile("" ::: "memory");
            const f32x4* xr = (const f32x4*)(x + (size_t)m * D) + lane; const f32x4* wn = (const f32x4*)pre_mix_norm + lane;
            f32x4 v[4]; float s = 0.f;
#pragma unroll
            for (int j = 0; j < 4; ++j) { v[j] = xr[64 * j]; s += (v[j].x * v[j].x + v[j].y * v[j].y) + (v[j].z * v[j].z + v[j].w * v[j].w); }
            const float rstd = 1.0f / sqrtf(wave_sum(s) * (1.f / D) + EPS);
            unsigned long long* o8 = (unsigned long long*)(Ab + (size_t)m * D) + lane;
#pragma unroll
            for (int j = 0; j < 4; ++j) { v[j] = v[j] * rstd * wn[64 * j]; o8[64 * j] = (unsigned long long)pk2(v[j].x, v[j].y) | ((unsigned long long)pk2(v[j].z, v[j].w) << 32); }
            float myv = 0.f;
#pragma unroll
            for (int c = 0; c < 16; ++c) { float acc = 0.f;
#pragma unroll
                for (int j = 0; j < 4; ++j) { const f32x4 w4 = *((const LAS f32x4*)(wl + c * 1024) + 64 * j + lane); acc += (v[j].x * w4.x + v[j].y * w4.y) + (v[j].z * w4.z + v[j].w * w4.w); }
                acc = wave_sum(acc); if (lane == c) myv = acc; }
            if (lane < 16) LR[(size_t)m * 16 + lane] = myv;
        }
    }
    SEAM(0);
    if (IN(1)) {
        pg8::Gemm g{Ab, Win_t, M, NINP, D, D}; pg8::StaticOrder S; S.init(M, NINP, G, bx);
        pg8::EpiInProj E{U, VA, Qb, Kb, VB, OG, GA, GB};
        pg8::gemm_phase<pg8::EpiInProj, pg8::StaticOrder, true, true>(L + RING_OFF, g, S, E);
    }
    SEAM(1);
    if (IN(2)) {
        float* Wl = (float*)(lds + RING_OFF);
        float* vn = (float*)(lds + RING_OFF + 66048);
        float* st = (float*)(lds + RING_OFF + 66048 + 32768);
        for (int it = vcu; it < 1024; it += G) {
            const int g = it & 7, c = (it >> 3) & 63, b = it >> 9; const size_t r0 = (size_t)b * SEQ + (size_t)c * 128;
            for (int idx = tid; idx < 128 * 128; idx += NTHR) { const int t = idx >> 7, s = idx & 127; Wl[t * 129 + s] = (s <= t) ? a_sw[(size_t)(g * 128 + t) * 128 + s] : 0.f; }
            const int row = tid >> 2, q = tid & 3;
            { const v4u* vp = (const v4u*)(VA + (r0 + row) * AW + q * 128); float s1 = 0.f, s2 = 0.f;
#pragma unroll 4
              for (int i = 0; i < 16; ++i) { const v4u w = vp[i];
#pragma unroll
                  for (int e = 0; e < 4; ++e) { const float a = bflo(w[e]), bq = bfhi(w[e]); s1 += a + bq; s2 += a * a + bq * bq; } }
              s1 += __shfl_xor(s1, 1); s2 += __shfl_xor(s2, 1); s1 += __shfl_xor(s1, 2); s2 += __shfl_xor(s2, 2);
              const float mean = s1 * (1.f / AW), var = s2 * (1.f / AW) - mean * mean; const float rstd = 1.0f / sqrtf(fmaxf(var, 0.f) + EPS);
              const v4u* gp = (const v4u*)(VA + (r0 + row) * AW + g * 64 + q * 16);
#pragma unroll
              for (int h = 0; h < 2; ++h) { const v4u w = gp[h];
#pragma unroll
                  for (int e = 0; e < 4; ++e) { const int ch = g * 64 + q * 16 + h * 8 + 2 * e;
                      vn[row * 64 + q * 16 + h * 8 + 2 * e] = (bflo(w[e]) - mean) * rstd * a_ln_g[ch] + a_ln_b[ch];
                      vn[row * 64 + q * 16 + h * 8 + 2 * e + 1] = (bfhi(w[e]) - mean) * rstd * a_ln_g[ch + 1] + a_ln_b[ch + 1]; } }
            }
            __syncthreads();
            float acc[16];
#pragma unroll
            for (int i = 0; i < 16; ++i) acc[i] = 0.f;
            const int smax = wave * 16 + 16;
            for (int s = 0; s < smax; ++s) { const float w = Wl[row * 129 + s];
#pragma unroll
                for (int i = 0; i < 16; ++i) acc[i] += w * vn[s * 64 + q * 16 + i]; }
            const float sb = a_sb[g * 128 + row];
            v4u* up = (v4u*)(U + (r0 + row) * AW + g * 64 + q * 16);
#pragma unroll
            for (int h = 0; h < 2; ++h) { v4u w = up[h];
#pragma unroll
                for (int e = 0; e < 4; ++e) w[e] = pk2(bflo(w[e]) * (acc[h * 8 + 2 * e] + sb), bfhi(w[e]) * (acc[h * 8 + 2 * e + 1] + sb));
                up[h] = w; }
            __syncthreads();
        }
        float* red = (float*)(lds + RING_OFF);
        for (int w = vcu; w < 128; w += G) {
            const int bh = w >> 4, js = w & 15, b = bh >> 2, h = bh & 3; const int d = tid & 127, jq = tid >> 7;
            float wg[16];
#pragma unroll
            for (int r = 0; r < 16; ++r) wg[r] = b_gk[r * BKEY + h * 128 + d];
            const float bias = b_gkb[h * 128 + d];
            float S0 = 0.f, S1 = 0.f, S2 = 0.f, S3 = 0.f;
            __syncthreads();
            for (int tt = 0; tt < SEQ / 4; ++tt) {
                float p[4][4];
#pragma unroll
                for (int i4 = 0; i4 < 4; ++i4) { const size_t rowi = (size_t)b * SEQ + 4 * tt + i4;
                    const f32x4* lrp = (const f32x4*)(LR + rowi * 16); float xg = bias;
#pragma unroll
                    for (int r4 = 0; r4 < 4; ++r4) { const f32x4 l4 = lrp[r4]; xg += l4.x * wg[4 * r4] + l4.y * wg[4 * r4 + 1] + l4.z * wg[4 * r4 + 2] + l4.w * wg[4 * r4 + 3]; }
                    const float ls = fminf(xg, 0.f) - log1pf(__expf(-fabsf(xg))); const float a = __expf(ls * (1.f / 16.f));
                    const float qv = bf2f(Qb[rowi * BKEY + h * 128 + d]), kv = bf2f(Kb[rowi * BKEY + h * 128 + d]);
                    const uint2 vv = *(const uint2*)(VB + rowi * BVAL + h * 256 + js * 16 + jq * 4);
                    S0 = a * S0 + kv * bflo(vv.x); S1 = a * S1 + kv * bfhi(vv.x); S2 = a * S2 + kv * bflo(vv.y); S3 = a * S3 + kv * bfhi(vv.y);
                    p[i4][0] = qv * S0; p[i4][1] = qv * S1; p[i4][2] = qv * S2; p[i4][3] = qv * S3; }
                const int bufo = (tt & 1) * 128;
#pragma unroll
                for (int i4 = 0; i4 < 4; ++i4)
#pragma unroll
                    for (int e = 0; e < 4; ++e) { const float r = wave_sum(p[i4][e]); if (lane == 0) red[bufo + wave * 16 + i4 * 4 + e] = r; }
                __syncthreads();
                if (tid < 64) { const int i4 = tid >> 4, jq2 = (tid >> 2) & 3, e = tid & 3;
                    const float o = red[bufo + (2 * jq2) * 16 + i4 * 4 + e] + red[bufo + (2 * jq2 + 1) * 16 + i4 * 4 + e];
                    Of[((size_t)b * SEQ + 4 * tt + i4) * BVAL + h * 256 + js * 16 + jq2 * 4 + e] = o; }
            }
            __syncthreads();
        }
    }
    SEAM(2);
    if (IN(3)) {
        for (int m = gw; m < M; m += NGW) {
            const f32x4* orow = (const f32x4*)(Of + (size_t)m * BVAL) + lane; const f32x4 wn = ((const f32x4*)b_onorm)[lane];
            const uint2* gp = (const uint2*)(OG + (size_t)m * BVAL) + lane; uint2* op = (uint2*)(VB + (size_t)m * BVAL) + lane;
#pragma unroll
            for (int j = 0; j < 4; ++j) { const f32x4 v = orow[64 * j]; const float ss = wave_sum((v.x * v.x + v.y * v.y) + (v.z * v.z + v.w * v.w));
                const float rstd = 1.0f / sqrtf(ss * (1.f / 256.f) + EPS); const uint2 gg = gp[64 * j];
                uint2 o; o.x = pk2(v.x * rstd * wn.x * bflo(gg.x), v.y * rstd * wn.y * bfhi(gg.x)); o.y = pk2(v.z * rstd * wn.z * bflo(gg.y), v.w * rstd * wn.w * bfhi(gg.y)); op[64 * j] = o; }
        }
    }
    SEAM(3);
    if (IN(4)) {
        { pg8::Gemm g{U, Aout_t, M, D, AW, AW}; pg8::StaticOrder S; S.init(M, D, G, bx); pg8::EpiGateMul E{GA, Tf, D};
          pg8::gemm_phase<pg8::EpiGateMul, pg8::StaticOrder, true, true>(L + RING_OFF, g, S, E); }
        { pg8::Gemm g{VB, Bout_t, M, D, D, D}; pg8::StaticOrder S; S.init(M, D, G, bx); pg8::EpiGateMulAdd E{GB, Tf, MB, D};
          pg8::gemm_phase<pg8::EpiGateMulAdd, pg8::StaticOrder, true, true>(L + RING_OFF, g, S, E); }
    }
    SEAM(4);
    if (IN(5)) {
        pg8::Gemm g{MB, Wmix_t, M, D, D, D}; pg8::StaticOrder S; S.init(M, D, G, bx); pg8::EpiF32 E{MIXED, D};
        pg8::gemm_phase<pg8::EpiF32, pg8::StaticOrder, true, true>(L + RING_OFF, g, S, E);
    }
    SEAM(5);
    if (IN(6)) {
        for (int m = gw; m < M; m += NGW) {
            const f32x4* mr = (const f32x4*)(MIXED + (size_t)m * D) + lane; const f32x4* xr = (const f32x4*)(x + (size_t)m * D) + lane;
            f32x4 v[4]; float s = 0.f;
#pragma unroll
            for (int j = 0; j < 4; ++j) { v[j] = mr[64 * j]; s += (v[j].x * v[j].x + v[j].y * v[j].y) + (v[j].z * v[j].z + v[j].w * v[j].w); }
            const float rstd = 1.0f / sqrtf(wave_sum(s) * (1.f / D) + EPS); float s2 = 0.f;
            f32x4* orow = (f32x4*)(out + (size_t)m * D) + lane;
#pragma unroll
            for (int j = 0; j < 4; ++j) { v[j] = xr[64 * j] + v[j] * rstd * ((const f32x4*)post_mix_norm)[64 * j + lane]; orow[64 * j] = v[j]; s2 += (v[j].x * v[j].x + v[j].y * v[j].y) + (v[j].z * v[j].z + v[j].w * v[j].w); }
            const float rstd2 = 1.0f / sqrtf(wave_sum(s2) * (1.f / D) + EPS);
            unsigned long long* o8 = (unsigned long long*)(Cb + (size_t)m * D) + lane;
#pragma unroll
            for (int j = 0; j < 4; ++j) { const f32x4 c4 = v[j] * rstd2 * ((const f32x4*)pre_ffn_norm)[64 * j + lane]; o8[64 * j] = (unsigned long long)pk2(c4.x, c4.y) | ((unsigned long long)pk2(c4.z, c4.w) << 32); }
        }
    }
    SEAM(6);
#pragma unroll 1
    for (int half = 0; half < 2; ++half) {
        if (IN(7 + 2 * half)) {
            pg8::Gemm g{Cb, Wup_t + (size_t)half * NHALF * D, M, NHALF, D, D}; pg8::StaticOrder S; S.init(M, NHALF, G, bx); pg8::EpiPlain E{RAW, NHALF};
            pg8::gemm_phase<pg8::EpiPlain, pg8::StaticOrder, true, true>(L + RING_OFF, g, S, E);
        }
        SEAM(7 + 2 * half);
        if (IN(8 + 2 * half)) {
            const size_t NGT = (size_t)G * NTHR;
            for (size_t i = (size_t)vcu * NTHR + tid; i < (size_t)M * 176; i += NGT) {
                const int oct = (int)(i % 176); const size_t row = i / 176; const int tl = (int)(row & (SEQ - 1));
                const int cl = oct * 8, j = cl >> 7, r = cl & 127; const int ch = half * 1408 + cl;
                const bf16* rp = RAW + row * NHALF + 256 * j + r;
                float yg[8], yv[8];
                { const f32x4 b0 = *(const f32x4*)(conv_b + ch), b1 = *(const f32x4*)(conv_b + ch + 4), c0 = *(const f32x4*)(conv_b + DFF + ch), c1 = *(const f32x4*)(conv_b + DFF + ch + 4);
                  yg[0] = b0.x; yg[1] = b0.y; yg[2] = b0.z; yg[3] = b0.w; yg[4] = b1.x; yg[5] = b1.y; yg[6] = b1.z; yg[7] = b1.w;
                  yv[0] = c0.x; yv[1] = c0.y; yv[2] = c0.z; yv[3] = c0.w; yv[4] = c1.x; yv[5] = c1.y; yv[6] = c1.z; yv[7] = c1.w; }
#pragma unroll
                for (int tap = 0; tap < 3; ++tap) { const int back = 2 - tap; if (tl >= back) {
                    const v4u wg4 = *(const v4u*)(rp - (size_t)back * NHALF), wv4 = *(const v4u*)(rp - (size_t)back * NHALF + 128);
                    const float* cwg = conv_w + (size_t)tap * NUP + ch; const float* cwv = conv_w + (size_t)tap * NUP + DFF + ch;
#pragma unroll
                    for (int e = 0; e < 4; ++e) { yg[2 * e] += cwg[2 * e] * bflo(wg4[e]); yg[2 * e + 1] += cwg[2 * e + 1] * bfhi(wg4[e]); yv[2 * e] += cwv[2 * e] * bflo(wv4[e]); yv[2 * e + 1] += cwv[2 * e + 1] * bfhi(wv4[e]); } } }
                v4u o;
#pragma unroll
                for (int e = 0; e < 4; ++e) o[e] = pk2(gelu_t(yg[2 * e]) * yv[2 * e], gelu_t(yg[2 * e + 1]) * yv[2 * e + 1]);
                *(v4u*)(ACT + row * DFF + ch) = o;
            }
        }
        SEAM(8 + 2 * half);
    }
    if (IN(11)) {
        pg8::Gemm g{ACT, Wdown_t, M, D, DFF, DFF}; pg8::StaticOrder S; S.init(M, D, G, bx); pg8::EpiPlain E{FB, D};
        pg8::gemm_phase<pg8::EpiPlain, pg8::StaticOrder, true, true>(L + RING_OFF, g, S, E);
    }
    SEAM(11);
    if (IN(12)) {
        for (int m = gw; m < M; m += NGW) {
            const uint2* fr2 = (const uint2*)(FB + (size_t)m * D) + lane; f32x4* orow = (f32x4*)(out + (size_t)m * D) + lane;
            f32x4 v[4]; float s = 0.f;
#pragma unroll
            for (int j = 0; j < 4; ++j) { const uint2 w = fr2[64 * j]; v[j] = (f32x4){bflo(w.x), bfhi(w.x), bflo(w.y), bfhi(w.y)}; s += (v[j].x * v[j].x + v[j].y * v[j].y) + (v[j].z * v[j].z + v[j].w * v[j].w); }
            const float rstd = 1.0f / sqrtf(wave_sum(s) * (1.f / D) + EPS);
            unsigned long long* o8 = (unsigned long long*)(H2B + (size_t)m * D) + lane;
#pragma unroll
            for (int j = 0; j < 4; ++j) { const f32x4 h = orow[64 * j] + v[j] * rstd * ((const f32x4*)post_ffn_norm)[64 * j + lane]; orow[64 * j] = h; o8[64 * j] = (unsigned long long)pk2(h.x, h.y) | ((unsigned long long)pk2(h.z, h.w) << 32); }
        }
    }
    SEAM(12);
    if (IN(13)) {
        { pg8::Gemm g{H2B, Wpleg_t, M, D, D, D}; pg8::StaticOrder S; S.init(M, D, G, bx); pg8::EpiF32 E{GS, D};
          pg8::gemm_phase<pg8::EpiF32, pg8::StaticOrder, true, true>(L + RING_OFF, g, S, E); }
        { pg8::Gemm g{PB, Wple_t, M, D, PLED, PLED}; pg8::StaticOrder S; S.init(M, D, G, bx); pg8::EpiF32 E{PV, D};
          pg8::gemm_phase<pg8::EpiF32, pg8::StaticOrder, true, true>(L + RING_OFF, g, S, E); }
    }
    SEAM(13);
    if (IN(14)) {
        for (int m = gw; m < M; m += NGW) {
            const f32x4* gr = (const f32x4*)(GS + (size_t)m * D) + lane; const f32x4* pr = (const f32x4*)(PV + (size_t)m * D) + lane; f32x4* orow = (f32x4*)(out + (size_t)m * D) + lane;
            f32x4 v[4]; float s = 0.f;
#pragma unroll
            for (int j = 0; j < 4; ++j) { const f32x4 g4 = gr[64 * j], p4 = pr[64 * j]; v[j] = (f32x4){sigm(g4.x) * p4.x, sigm(g4.y) * p4.y, sigm(g4.z) * p4.z, sigm(g4.w) * p4.w}; s += (v[j].x * v[j].x + v[j].y * v[j].y) + (v[j].z * v[j].z + v[j].w * v[j].w); }
            const float rstd = 1.0f / sqrtf(wave_sum(s) * (1.f / D) + EPS);
#pragma unroll
            for (int j = 0; j < 4; ++j) orow[64 * j] = orow[64 * j] + v[j] * rstd * ((const f32x4*)post_ple_norm)[64 * j + lane];
        }
    }
#undef IN
#undef SEAM
}

extern "C" void kernel_launch(void* const* d_in, const int* in_sizes, int n_in, void* d_out, int out_size, void* d_ws, size_t ws_size, hipStream_t stream) {
    static int grid = 0;
    if (grid == 0) {
        if (n_in != 24 || in_sizes[0] != M * D || out_size != M * D || ws_size < WS_END) { fprintf(stderr, "kernel_launch: unexpected shapes (n_in %d in0 %d out %d ws %zu)\n", n_in, n_in > 0 ? in_sizes[0] : -1, out_size, ws_size); grid = -1; return; }
        int dev = 0, cus = 0, per_cu = 0;
        if (hipGetDevice(&dev) != hipSuccess || hipDeviceGetAttribute(&cus, hipDeviceAttributeMultiprocessorCount, dev) != hipSuccess) { grid = -1; return; }
        if (hipFuncSetAttribute((const void*)fwd_kernel, hipFuncAttributeMaxDynamicSharedMemorySize, LDS_BYTES) != hipSuccess) { fprintf(stderr, "kernel_launch: hipFuncSetAttribute failed\n"); grid = -1; return; }
        if (hipOccupancyMaxActiveBlocksPerMultiprocessor(&per_cu, (const void*)fwd_kernel, NTHR, LDS_BYTES) != hipSuccess || per_cu < 1) fprintf(stderr, "kernel_launch: occupancy query says %d per CU\n", per_cu);
        (void)hipGetLastError();
        grid = cus;
    }
    if (grid < 0) return;
    (void)hipMemsetAsync((char*)d_ws + WS_CTL, 0, CTL_ZERO_BYTES, stream);
    Args a{};
    for (int i = 0; i < 24; ++i) a.in[i] = (const float*)d_in[i];
    a.out = (float*)d_out; a.ws = (unsigned char*)d_ws;
    if (N_LAUNCHES == 1) { a.ph_lo = 0; a.ph_hi = NPHASES; a.li = 0; hipLaunchKernelGGL(fwd_kernel, dim3(grid), dim3(NTHR), LDS_BYTES, stream, a); }
    else for (int li = 0; li < NPHASES; ++li) { a.ph_lo = li; a.ph_hi = li + 1; a.li = li; hipLaunchKernelGGL(fwd_kernel, dim3(grid), dim3(NTHR), LDS_BYTES, stream, a); }
}
```

```cpp
#include <hip/hip_runtime.h>
#include <cstdio>
#include <cstdint>
namespace pg8 {
#define PG8_LAS __attribute__((address_space(3)))
typedef unsigned short bf16_t;
typedef short bf16x8 __attribute__((ext_vector_type(8)));
typedef float f32x4 __attribute__((ext_vector_type(4)));
typedef unsigned u32x4 __attribute__((ext_vector_type(4)));
constexpr int BM = 256, BK = 64, HALF = 128, HTB = HALF * BK * 2  , STAGE_BYTES = 8 * HTB, NXCD = 8, WGM = 8;

__host__ __device__ __forceinline__ int lds_byte(int r, int c) { const int st = (r >> 4) * 2 + (c >> 5), rr = r & 15, cc = c & 31, ob = rr * 64 + cc * 2; return st * 1024 + (ob ^ (((ob >> 9) & 1) << 5)); }
__host__ __device__ __forceinline__ void stage_rc(int b, int& R, int& C) { const int st = b / 1024, sb = b % 1024, swz = sb ^ (((sb >> 9) & 1) << 5); R = (st >> 1) * 16 + swz / 64; C = (st & 1) * 32 + (swz % 64) / 2; }
__host__ __device__ __forceinline__ int perm32(int rho) { const int n = rho >> 4, i = rho & 15; return 8 * (i >> 2) + 4 * n + (i & 3); }

struct Unit { int pm, pn; };
struct Gemm { const bf16_t* A; const bf16_t* Bt; int M, N, K, lda; };

struct StaticOrder {
    int nM, nN, nwg, G, c;
    __host__ __device__ void init(int M, int N, int G_, int c_) { nM = M / BM; nN = N / BM; nwg = nM * nN; G = G_; c = c_; }
    __host__ __device__ bool next(int i, Unit& u) const {
        const long L = (long)i * G + c; if (L >= nwg) return false;
        int wgid = (int)L; { const int q = nwg / NXCD, r = nwg % NXCD, xcd = wgid % NXCD, off = wgid / NXCD; wgid = (xcd < r ? xcd * (q + 1) : r * (q + 1) + (xcd - r) * q) + off; }
        const int nig = WGM * nN, gid = wgid / nig, fm = gid * WGM, gsz = (nM - fm) < WGM ? (nM - fm) : WGM;
        u.pm = fm + ((wgid % nig) % gsz); u.pn = (wgid % nig) / gsz; return true;
    }
    __device__ __forceinline__ void a_ready(const Unit&) const {}
    __device__ __forceinline__ void done(const Unit&) const {}
};

__device__ __forceinline__ unsigned cvt_pk_bf16(float lo, float hi) { unsigned r; asm volatile("v_cvt_pk_bf16_f32 %0, %1, %2" : "=v"(r) : "v"(lo), "v"(hi)); return r; }
typedef float f32x2 __attribute__((ext_vector_type(2)));
template <class Epi, class Sched, bool ALIGN_EPI = false, bool SP2 = false>
__device__ __forceinline__ void gemm_phase(PG8_LAS unsigned char* lds, const Gemm g, const Sched& S, const Epi& E) {
    const int tid = threadIdx.x, wid = __builtin_amdgcn_readfirstlane(tid >> 6), lane = tid & 63, wr = wid >> 2, wc = wid & 3, fr = lane & 15, fq = lane >> 4;
    const int K = g.K, nt = K / BK;
    unsigned voffA[2], voffB[2];
#pragma unroll
    for (int i = 0; i < 2; ++i) { int R, C; stage_rc(tid * 16 + i * 8192, R, C); const int Rb = Epi::PERM ? ((R & ~31) + perm32(R & 31)) : R;
        voffA[i] = (unsigned)(R * g.lda + C) * 2u; voffB[i] = (unsigned)(Rb * K + C) * 2u; }
    const size_t kstep = (size_t)(BK * 2);
    const size_t hstepB = (size_t)HALF * K * 2, hstepA = (size_t)HALF * g.lda * 2;
    const size_t tstepA = 2 * hstepA, tstepB = 2 * hstepB;
    const unsigned ldsw = (unsigned)wid * 1024u;
    const int aoff = lds_byte(wr * 64 + fr, fq * 8), boff = lds_byte(wc * 32 + fr, fq * 8);
#define PG8_SA(b, h) (((b) * 2 + (h)) * HTB)
#define PG8_SB(b, h) ((4 + (b) * 2 + (h)) * HTB)
#define PG8_STAGE(bufoff, gbase, voff) do { _Pragma("unroll") for (int _i = 0; _i < 2; ++_i) \
        __builtin_amdgcn_global_load_lds((const unsigned*)((const char*)(gbase) + (voff)[_i]), (PG8_LAS unsigned*)(lds + (bufoff) + ldsw + _i * 8192), 16, 0, 0); } while (0)
#define PG8_LDA(dst, b, h) do { _Pragma("unroll") for (int m = 0; m < 4; ++m) _Pragma("unroll") for (int k = 0; k < 2; ++k) dst[m][k] = *(const PG8_LAS bf16x8*)(lds + PG8_SA(b, h) + aoff + m * 2048 + k * 1024); } while (0)
#define PG8_LDB(dst, b, h) do { _Pragma("unroll") for (int n = 0; n < 2; ++n) _Pragma("unroll") for (int k = 0; k < 2; ++k) dst[n][k] = *(const PG8_LAS bf16x8*)(lds + PG8_SB(b, h) + boff + n * 2048 + k * 1024); } while (0)
#define PG8_MMA(ai, bj, At, Bt) do { __builtin_amdgcn_s_setprio(1); _Pragma("unroll") for (int m = 0; m < 4; ++m) _Pragma("unroll") for (int n = 0; n < 2; ++n) _Pragma("unroll") for (int k = 0; k < 2; ++k) \
        acc[ai][bj][m][n] = __builtin_amdgcn_mfma_f32_16x16x32_bf16(Bt[n][k], At[m][k], acc[ai][bj][m][n], 0, 0, 0); __builtin_amdgcn_s_setprio(0); } while (0)
#define PG8_WAIT_V(n) asm volatile("s_waitcnt vmcnt(" #n ")" ::: "memory")
#define PG8_WAIT_L(n) asm volatile("s_waitcnt lgkmcnt(" #n ")" ::: "memory")
#define PG8_BAR __builtin_amdgcn_s_barrier()
#define PG8_SCHED __builtin_amdgcn_sched_barrier(0)
    Unit cur, nxt; int ui = 0;
    if (!S.next(0, cur)) return;
    f32x4 acc[2][2][4][2];
#pragma unroll
    for (int a = 0; a < 2; ++a)
#pragma unroll
        for (int b = 0; b < 2; ++b)
#pragma unroll
            for (int m = 0; m < 4; ++m)
#pragma unroll
                for (int n = 0; n < 2; ++n) acc[a][b][m][n] = (f32x4){0.f, 0.f, 0.f, 0.f};
    bf16x8 At[4][2], B0[2][2], B1[2][2];
    const char* cA = (const char*)g.A + (size_t)cur.pm * tstepA; const char* cB = (const char*)g.Bt + (size_t)cur.pn * tstepB;
    S.a_ready(cur);
    if constexpr (SP2) {
        PG8_STAGE(PG8_SB(0, 0), cB, voffB); PG8_STAGE(PG8_SB(0, 1), cB + hstepB, voffB); PG8_STAGE(PG8_SA(0, 0), cA, voffA); PG8_STAGE(PG8_SA(0, 1), cA + hstepA, voffA);
        if (wr == 1) PG8_BAR;
        PG8_WAIT_V(2); PG8_BAR;
        PG8_STAGE(PG8_SB(1, 0), cB + kstep, voffB); PG8_STAGE(PG8_SA(1, 0), cA + kstep, voffA); PG8_STAGE(PG8_SB(1, 1), cB + hstepB + kstep, voffB);
        PG8_WAIT_V(6); PG8_BAR;
    } else {
        PG8_STAGE(PG8_SB(0, 0), cB, voffB); PG8_STAGE(PG8_SA(0, 0), cA, voffA); PG8_STAGE(PG8_SB(0, 1), cB + hstepB, voffB); PG8_STAGE(PG8_SA(0, 1), cA + hstepA, voffA);
        if (wr == 1) PG8_BAR;
        PG8_WAIT_V(4); PG8_BAR;
        PG8_STAGE(PG8_SB(1, 0), cB + kstep, voffB); PG8_STAGE(PG8_SA(1, 0), cA + kstep, voffA); PG8_STAGE(PG8_SB(1, 1), cB + hstepB + kstep, voffB);
        PG8_WAIT_V(6); PG8_BAR;
    }
    for (;;) {
        const bool has_next = S.next(ui + 1, nxt);
        const char* nA = has_next ? (const char*)g.A + (size_t)nxt.pm * tstepA : cA; const char* nB = has_next ? (const char*)g.Bt + (size_t)nxt.pn * tstepB : cB;
        for (int t = 0; t < nt; t += 2) {
            const bool last = (t == nt - 2);
            const char* a1 = cA + (size_t)(t + 1) * kstep;
            const char* a2 = last ? nA : cA + (size_t)(t + 2) * kstep; const char* b2 = last ? nB : cB + (size_t)(t + 2) * kstep;
            const char* a3 = a2 + kstep; const char* b3 = b2 + kstep;
            if (last && has_next) S.a_ready(nxt);
            if constexpr (SP2) {
            PG8_LDB(B0, 0, 0); PG8_LDB(B1, 0, 1); PG8_SCHED; PG8_LDA(At, 0, 0); PG8_STAGE(PG8_SA(1, 1), a1 + hstepA, voffA);
            PG8_WAIT_V(8); PG8_WAIT_L(0); PG8_BAR; PG8_MMA(0, 0, At, B0); PG8_MMA(0, 1, At, B1); PG8_BAR; PG8_SCHED;
            PG8_LDA(At, 0, 1); PG8_STAGE(PG8_SB(0, 0), b2, voffB); PG8_STAGE(PG8_SB(0, 1), b2 + hstepB, voffB); PG8_STAGE(PG8_SA(0, 0), a2, voffA);
            PG8_WAIT_V(8); PG8_WAIT_L(0); PG8_BAR; PG8_MMA(1, 0, At, B0); PG8_MMA(1, 1, At, B1); PG8_BAR; PG8_SCHED;
            PG8_LDB(B0, 1, 0); PG8_LDB(B1, 1, 1); PG8_SCHED; PG8_LDA(At, 1, 0); PG8_STAGE(PG8_SA(0, 1), a2 + hstepA, voffA);
            PG8_WAIT_V(8); PG8_WAIT_L(0); PG8_BAR; PG8_MMA(0, 0, At, B0); PG8_MMA(0, 1, At, B1); PG8_BAR; PG8_SCHED;
            PG8_LDA(At, 1, 1); PG8_STAGE(PG8_SB(1, 0), b3, voffB); PG8_STAGE(PG8_SB(1, 1), b3 + hstepB, voffB); PG8_STAGE(PG8_SA(1, 0), a3, voffA);
            PG8_WAIT_V(8); PG8_WAIT_L(0); PG8_BAR; PG8_MMA(1, 0, At, B0); PG8_MMA(1, 1, At, B1); PG8_BAR; PG8_SCHED;
            } else {
            PG8_LDB(B0, 0, 0); PG8_SCHED; PG8_LDA(At, 0, 0); PG8_STAGE(PG8_SA(1, 1), a1 + hstepA, voffA);
            PG8_WAIT_L(8); PG8_BAR; PG8_WAIT_L(0); PG8_MMA(0, 0, At, B0); PG8_BAR; PG8_SCHED;
            PG8_LDB(B1, 0, 1); PG8_STAGE(PG8_SB(0, 0), b2, voffB);
            PG8_BAR; PG8_WAIT_L(0); PG8_MMA(0, 1, At, B1); PG8_BAR;
            PG8_LDA(At, 0, 1); PG8_STAGE(PG8_SA(0, 0), a2, voffA);
            PG8_BAR; PG8_WAIT_L(0); PG8_MMA(1, 0, At, B0); PG8_BAR; PG8_SCHED;
            PG8_STAGE(PG8_SB(0, 1), b2 + hstepB, voffB);
            PG8_WAIT_V(6); PG8_BAR; PG8_MMA(1, 1, At, B1); PG8_BAR;
            PG8_LDB(B0, 1, 0); PG8_SCHED; PG8_LDA(At, 1, 0); PG8_STAGE(PG8_SA(0, 1), a2 + hstepA, voffA);
            PG8_WAIT_L(8); PG8_BAR; PG8_WAIT_L(0); PG8_MMA(0, 0, At, B0); PG8_BAR; PG8_SCHED;
            PG8_LDB(B1, 1, 1); PG8_STAGE(PG8_SB(1, 0), b3, voffB);
            PG8_BAR; PG8_WAIT_L(0); PG8_MMA(0, 1, At, B1); PG8_BAR;
            PG8_LDA(At, 1, 1); PG8_STAGE(PG8_SA(1, 0), a3, voffA);
            PG8_BAR; PG8_WAIT_L(0); PG8_MMA(1, 0, At, B0); PG8_BAR; PG8_SCHED;
            PG8_STAGE(PG8_SB(1, 1), b3 + hstepB, voffB);
            PG8_WAIT_V(6); PG8_BAR; PG8_MMA(1, 1, At, B1); PG8_BAR;
            }
        }
        if constexpr (ALIGN_EPI) { if (wr == 0) PG8_BAR; }
        if constexpr (!Epi::AFTER_DRAIN) { E(acc, cur, wr, wc, fr, fq); S.done(cur); }
        if (!has_next) break;
#pragma unroll
        for (int a = 0; a < 2; ++a)
#pragma unroll
            for (int b = 0; b < 2; ++b)
#pragma unroll
                for (int m = 0; m < 4; ++m)
#pragma unroll
                    for (int n = 0; n < 2; ++n) acc[a][b][m][n] = (f32x4){0.f, 0.f, 0.f, 0.f};
        cur = nxt; cA = nA; cB = nB; ++ui;
        if constexpr (ALIGN_EPI) { if (wr == 1) PG8_BAR; }
    }
    PG8_WAIT_V(0);
    if constexpr (!ALIGN_EPI) { if (wr == 0) PG8_BAR; }
    PG8_BAR;
    if constexpr (Epi::AFTER_DRAIN) { E.fused(acc, cur, wr, wc, fr, fq, lds, wid, lane); S.done(cur); }
#undef PG8_SA
#undef PG8_SB
#undef PG8_STAGE
#undef PG8_LDA
#undef PG8_LDB
#undef PG8_MMA
#undef PG8_WAIT_V
#undef PG8_WAIT_L
#undef PG8_BAR
#undef PG8_SCHED
}
}
namespace pg8 {
__device__ __forceinline__ float sigm(float t) { return __builtin_amdgcn_rcpf(1.0f + __builtin_amdgcn_exp2f(-1.44269504f * t)); }
__device__ __forceinline__ float gelu_t(float x) { const float t = x * (1.5957691216f + 0.0713548163f * x * x); return x * sigm(t); }
struct EpiPlain {
    static constexpr bool PERM = true, AFTER_DRAIN = false;
    bf16_t* O; int ldc;
    __device__ __forceinline__ void operator()(const f32x4 (&acc)[2][2][4][2], const Unit& u, int wr, int wc, int fr, int fq) const {
        const int row0 = u.pm * BM + wr * 64 + fr, col0 = u.pn * BM + wc * 32 + 8 * fq;
#pragma unroll
        for (int ai = 0; ai < 2; ++ai)
#pragma unroll
            for (int m = 0; m < 4; ++m) { bf16_t* rowp = O + (size_t)(row0 + ai * HALF + m * 16) * ldc + col0;
#pragma unroll
                for (int bj = 0; bj < 2; ++bj) { const f32x4 v0 = acc[ai][bj][m][0], v1 = acc[ai][bj][m][1];
                    u32x4 w; w.x = cvt_pk_bf16(v0[0], v0[1]); w.y = cvt_pk_bf16(v0[2], v0[3]); w.z = cvt_pk_bf16(v1[0], v1[1]); w.w = cvt_pk_bf16(v1[2], v1[3]);
                    *(u32x4*)(rowp + bj * HALF) = w; } }
    }
};
struct EpiInProj {
    static constexpr bool PERM = true, AFTER_DRAIN = false;
    bf16_t *U, *VA, *Q, *K, *VB, *OG, *GA, *GB;
    __device__ __forceinline__ void operator()(const f32x4 (&acc)[2][2][4][2], const Unit& u, int wr, int wc, int fr, int fq) const {
        const int pn = u.pn; bf16_t* base; int ldc, colt, mode;
        if (pn < 2) { base = U; ldc = 512; colt = pn * 256; mode = 2; }
        else if (pn < 4) { base = VA; ldc = 512; colt = (pn - 2) * 256; mode = 2; }
        else if (pn < 6) { base = Q; ldc = 512; colt = (pn - 4) * 256; mode = 1; }
        else if (pn < 8) { base = K; ldc = 512; colt = (pn - 6) * 256; mode = 0; }
        else if (pn < 12) { base = VB; ldc = 1024; colt = (pn - 8) * 256; mode = 0; }
        else if (pn < 16) { base = OG; ldc = 1024; colt = (pn - 12) * 256; mode = 3; }
        else if (pn < 20) { base = GA; ldc = 1024; colt = (pn - 16) * 256; mode = 4; }
        else { base = GB; ldc = 1024; colt = (pn - 20) * 256; mode = 4; }
        const int row0 = u.pm * BM + wr * 64 + fr, col0 = colt + wc * 32 + 8 * fq;
        const float sc = (mode == 1) ? 0.08838834764831845f : 1.0f;
#pragma unroll
        for (int ai = 0; ai < 2; ++ai)
#pragma unroll
            for (int m = 0; m < 4; ++m) { bf16_t* rowp = base + (size_t)(row0 + ai * HALF + m * 16) * ldc + col0;
#pragma unroll
                for (int bj = 0; bj < 2; ++bj) { float v[8];
#pragma unroll
                    for (int e = 0; e < 4; ++e) { v[e] = acc[ai][bj][m][0][e]; v[4 + e] = acc[ai][bj][m][1][e]; }
                    if (mode <= 1) {
#pragma unroll
                        for (int e = 0; e < 8; ++e) v[e] *= sc;
                    } else if (mode == 2) {
#pragma unroll
                        for (int e = 0; e < 8; ++e) v[e] = gelu_t(v[e]);
                    } else if (mode == 3) {
#pragma unroll
                        for (int e = 0; e < 8; ++e) v[e] = v[e] * sigm(v[e]);
                    } else {
#pragma unroll
                        for (int e = 0; e < 8; ++e) v[e] = sigm(v[e]);
                    }
                    u32x4 w; w.x = cvt_pk_bf16(v[0], v[1]); w.y = cvt_pk_bf16(v[2], v[3]); w.z = cvt_pk_bf16(v[4], v[5]); w.w = cvt_pk_bf16(v[6], v[7]);
                    *(u32x4*)(rowp + bj * HALF) = w; } }
    }
};
struct EpiF32 {
    static constexpr bool PERM = false, AFTER_DRAIN = false;
    float* C; int ldc;
    __device__ __forceinline__ void operator()(const f32x4 (&acc)[2][2][4][2], const Unit& u, int wr, int wc, int fr, int fq) const {
        const int row0 = u.pm * BM + wr * 64 + fr, col0 = u.pn * BM + wc * 32 + 4 * fq;
#pragma unroll
        for (int ai = 0; ai < 2; ++ai)
#pragma unroll
            for (int m = 0; m < 4; ++m) { float* rowp = C + (size_t)(row0 + ai * HALF + m * 16) * ldc + col0;
#pragma unroll
                for (int bj = 0; bj < 2; ++bj)
#pragma unroll
                    for (int n = 0; n < 2; ++n) *(f32x4*)(rowp + bj * HALF + n * 16) = acc[ai][bj][m][n]; }
    }
};
__device__ __forceinline__ float bfx(unsigned w, int hi) { return __uint_as_float(hi ? (w & 0xffff0000u) : (w << 16)); }
struct EpiGateMul {
    static constexpr bool PERM = false, AFTER_DRAIN = false;
    const bf16_t* G; float* T; int ldc;
    __device__ __forceinline__ void operator()(const f32x4 (&acc)[2][2][4][2], const Unit& u, int wr, int wc, int fr, int fq) const {
        const int row0 = u.pm * BM + wr * 64 + fr, col0 = u.pn * BM + wc * 32 + 4 * fq;
#pragma unroll
        for (int ai = 0; ai < 2; ++ai)
#pragma unroll
            for (int m = 0; m < 4; ++m) { const size_t off = (size_t)(row0 + ai * HALF + m * 16) * ldc + col0;
#pragma unroll
                for (int bj = 0; bj < 2; ++bj)
#pragma unroll
                    for (int n = 0; n < 2; ++n) { const uint2 g = *(const uint2*)(G + off + bj * HALF + n * 16); const f32x4 a = acc[ai][bj][m][n];
                        f32x4 o; o[0] = a[0] * bfx(g.x, 0); o[1] = a[1] * bfx(g.x, 1); o[2] = a[2] * bfx(g.y, 0); o[3] = a[3] * bfx(g.y, 1);
                        *(f32x4*)(T + off + bj * HALF + n * 16) = o; } }
    }
};
struct EpiGateMulAdd {
    static constexpr bool PERM = false, AFTER_DRAIN = false;
    const bf16_t* G; const float* T; bf16_t* O; int ldc;
    __device__ __forceinline__ void operator()(const f32x4 (&acc)[2][2][4][2], const Unit& u, int wr, int wc, int fr, int fq) const {
        const int row0 = u.pm * BM + wr * 64 + fr, col0 = u.pn * BM + wc * 32 + 4 * fq;
#pragma unroll
        for (int ai = 0; ai < 2; ++ai)
#pragma unroll
            for (int m = 0; m < 4; ++m) { const size_t off = (size_t)(row0 + ai * HALF + m * 16) * ldc + col0;
#pragma unroll
                for (int bj = 0; bj < 2; ++bj)
#pragma unroll
                    for (int n = 0; n < 2; ++n) { const uint2 g = *(const uint2*)(G + off + bj * HALF + n * 16); const f32x4 a = acc[ai][bj][m][n]; const f32x4 t = *(const f32x4*)(T + off + bj * HALF + n * 16);
                        uint2 o; o.x = cvt_pk_bf16(t[0] + a[0] * bfx(g.x, 0), t[1] + a[1] * bfx(g.x, 1)); o.y = cvt_pk_bf16(t[2] + a[2] * bfx(g.y, 0), t[3] + a[3] * bfx(g.y, 1));
                        *(uint2*)(O + off + bj * HALF + n * 16) = o; } }
    }
};
}
#define GAS __attribute__((address_space(1)))
#define LAS __attribute__((address_space(3)))
typedef unsigned short bf16;
typedef unsigned v4u __attribute__((ext_vector_type(4)));
typedef float f32x4 __attribute__((ext_vector_type(4)));
typedef short bf16x8 __attribute__((ext_vector_type(8)));
typedef GAS unsigned gu32;
typedef GAS unsigned long long gu64;
#define RLX_AGENT __ATOMIC_RELAXED, __HIP_MEMORY_SCOPE_AGENT
#define LDS_WAIT() asm volatile("s_waitcnt lgkmcnt(0)" ::: "memory")
#define VM_WAIT() asm volatile("s_waitcnt vmcnt(0)" ::: "memory")
__device__ __forceinline__ unsigned long long rt() { return __builtin_amdgcn_s_memrealtime(); }
__device__ __forceinline__ unsigned f2bf(float f) { unsigned u = __builtin_bit_cast(unsigned, f); return (u + 0x7fffu + ((u >> 16) & 1u)) >> 16; }
__device__ __forceinline__ unsigned pk2(float lo, float hi) { return f2bf(lo) | (f2bf(hi) << 16); }

#define XB_TMO      128
#define XB_XCNT(j)  (256  + 64 * (j))
#define XB_XSUB(j)  (1280 + 64 * (j))
#define XB_XGEN(j)  (2304 + 64 * (j))
#define XB_TOP      3328
#define XB_TOPGEN   3392
#define XCD_BAR_WORDS 3456
#define XB_SPIN_CAP (1u << 18)

__device__ __forceinline__ unsigned xb_ld(unsigned* p)              { return __hip_atomic_load(p, __ATOMIC_RELAXED, __HIP_MEMORY_SCOPE_AGENT); }
__device__ __forceinline__ unsigned xb_add(unsigned* p, unsigned v) { return __hip_atomic_fetch_add(p, v, __ATOMIC_RELAXED, __HIP_MEMORY_SCOPE_AGENT); }
__device__ __forceinline__ unsigned xb_xcc_id() { return (unsigned)__builtin_amdgcn_s_getreg((3 << 11) | 20) & 0xFu; }
#define XB_SPIN(cond, bar) do { unsigned _sp = 0; while (cond) { __builtin_amdgcn_s_sleep(1); \
    if ((++_sp & 255u) == 0u) { if (xb_ld(&(bar)[XB_TMO])) break; if (_sp > XB_SPIN_CAP) { atomicAdd(&(bar)[XB_TMO], 1u); break; } } } } while (0)

struct XcdBarrier {
    unsigned* bar; unsigned x;
    volatile LAS unsigned* st;
};

__device__ __forceinline__ XcdBarrier xcd_barrier_post(unsigned* bar, volatile LAS unsigned* st) {
    XcdBarrier b; b.bar = bar; b.x = xb_xcc_id(); b.st = st;
    if (threadIdx.x == 0) (void)xb_add(&bar[XB_XCNT(b.x)], 1u);
    return b;
}
__device__ __forceinline__ void xcd_barrier_complete(unsigned* bar, unsigned x, unsigned& nloc, unsigned& nx) {
    const unsigned G = gridDim.x * gridDim.y * gridDim.z;
    unsigned sum, cnt, mine, sp = 0u;
    for (;;) {
        sum = 0u; cnt = 0u; mine = 0u;
#pragma unroll
        for (unsigned j = 0; j < 16; ++j) { const unsigned c = xb_ld(&bar[XB_XCNT(j)]); sum += c; cnt += (c > 0u) ? 1u : 0u; mine = (j == x) ? c : mine; }
        if (sum == G) break;
        __builtin_amdgcn_s_sleep(1);
        if ((++sp & 255u) == 0u) { if (xb_ld(&bar[XB_TMO])) break; if (sp > XB_SPIN_CAP) { atomicAdd(&bar[XB_TMO], 1u); break; } }
    }
    nloc = mine > 0u ? mine : 1u; nx = cnt > 0u ? cnt : 1u;
}

__device__ __forceinline__ void xcd_barrier(const XcdBarrier& b) {
    asm volatile("s_waitcnt vmcnt(0)" ::: "memory");
    __syncthreads();
    if (threadIdx.x == 0) {
        unsigned* bar = b.bar;
        __builtin_amdgcn_s_waitcnt(0);
        unsigned nloc = b.st[0], nx = b.st[1];
        if (nloc == 0u) { xcd_barrier_complete(bar, b.x, nloc, nx); b.st[0] = nloc; b.st[1] = nx; }
        const unsigned old = xb_add(&bar[XB_XSUB(b.x)], 1u);
        const unsigned gen = old / nloc;
        if (old + 1u == (gen + 1u) * nloc) {
            __builtin_amdgcn_fence(__ATOMIC_RELEASE, "agent");
            asm volatile("s_waitcnt vmcnt(0)" ::: "memory");
            const unsigned og = xb_add(&bar[XB_TOP], 1u);
            const unsigned tg = og / nx;
            if (og + 1u == (tg + 1u) * nx) xb_add(&bar[XB_TOPGEN], 1u);
            else XB_SPIN(xb_ld(&bar[XB_TOPGEN]) == tg, bar);
            __builtin_amdgcn_fence(__ATOMIC_ACQUIRE, "agent");
            xb_add(&bar[XB_XGEN(b.x)], 1u);
            asm volatile("s_waitcnt vmcnt(0)" ::: "memory");
        } else {
            XB_SPIN(xb_ld(&bar[XB_XGEN(b.x)]) == gen, bar);
            __builtin_amdgcn_fence(__ATOMIC_ACQUIRE, "agent");
            asm volatile("s_waitcnt vmcnt(0)" ::: "memory");
        }
    }
    __syncthreads();
}
constexpr int NWAVES = 8, NTHR = NWAVES * 64;
constexpr int BATCH = 2, SEQ = 8192, D = 1024, M = BATCH * SEQ;
constexpr int INCOLS = 6160, NINP = 6144, AW = 512, BKEY = 512, BVAL = 1024, DFF = 2816, NUP = 5632, PLED = 256, NHALF = 2816;
constexpr float EPS = 1e-6f;
constexpr size_t MiB = 1u << 20;
constexpr size_t WS_CTL = 0, CTL_ZERO_BYTES = 128 * 1024;
constexpr size_t WS_DEC = 512 * 1024;
constexpr size_t WS_LR = 1 * MiB;
constexpr size_t WS_WIN = 2 * MiB, WS_AOUT = 14 * MiB, WS_BOUT = 15 * MiB, WS_WMIX = 17 * MiB, WS_WUP = 19 * MiB, WS_WDOWN = 30 * MiB, WS_WPLEG = 36 * MiB, WS_WPLE = 38 * MiB + 512 * 1024 - 512 * 1024;
constexpr size_t WS_WSB = 38 * MiB + 512 * 1024;
constexpr size_t WS_PB = 39 * MiB;
constexpr size_t WS_U = 48 * MiB, WS_VA = 64 * MiB, WS_Q = 80 * MiB, WS_K = 96 * MiB, WS_VB = 112 * MiB, WS_OG = 144 * MiB, WS_GA = 176 * MiB, WS_GB = 208 * MiB;
constexpr size_t WS_MB = 80 * MiB;
constexpr size_t WS_C = 48 * MiB;
constexpr size_t WS_MIXED = 144 * MiB;
constexpr size_t WS_RAW = 80 * MiB, WS_ACT = 168 * MiB;
constexpr size_t WS_FB = 48 * MiB;
constexpr size_t WS_H2B = 80 * MiB;
constexpr size_t WS_GS = 112 * MiB, WS_PV = 176 * MiB;
constexpr size_t WS_END = 256 * MiB;
static_assert(WS_WPLE + (size_t)D * PLED * 2 <= WS_PB && WS_PB + (size_t)M * PLED * 2 <= WS_U && WS_GB + (size_t)M * 1024 * 2 <= WS_END && WS_ACT + (size_t)M * DFF * 2 <= WS_END && WS_RAW + (size_t)M * NHALF * 2 <= WS_ACT, "ws map");
constexpr int CW_TMO = 0, CW_CODE = 1, CW_BAR = 4096;
constexpr int RING_OFF = 0, RING_BYTES = 131072, LDSCTL_OFF = RING_BYTES, MISC_OFF = LDSCTL_OFF + 320, LDS_BYTES = 147456;

__device__ __forceinline__ float wave_sum(float v) {
#pragma unroll
    for (int o = 1; o < 64; o <<= 1) v += __shfl_xor(v, o);
    return v;
}
__device__ __forceinline__ float bf2f(unsigned short h) { return __uint_as_float((unsigned)h << 16); }
__device__ __forceinline__ float bflo(unsigned w) { return __uint_as_float(w << 16); }
__device__ __forceinline__ float bfhi(unsigned w) { return __uint_as_float(w & 0xffff0000u); }
__device__ __forceinline__ float sigm(float t) { return 1.0f / (1.0f + __expf(-t)); }
__device__ __forceinline__ float gelu_t(float x) { const float t = x * (1.5957691216f + 0.0713548163f * x * x); return x * sigm(t); }


typedef short s16x4 __attribute__((ext_vector_type(4)));
typedef float f32x16 __attribute__((ext_vector_type(16)));
template <int PITCH>
__device__ __forceinline__ void tr_frag4(unsigned addr, bf16x8 (&f)[4]) {
    s16x4 a0, a1, a2, a3, a4, a5, a6, a7;
    asm volatile("ds_read_b64_tr_b16 %0, %8 offset:%9\n\tds_read_b64_tr_b16 %1, %8 offset:%10\n\tds_read_b64_tr_b16 %2, %8 offset:%11\n\tds_read_b64_tr_b16 %3, %8 offset:%12\n\t"
                 "ds_read_b64_tr_b16 %4, %8 offset:%13\n\tds_read_b64_tr_b16 %5, %8 offset:%14\n\tds_read_b64_tr_b16 %6, %8 offset:%15\n\tds_read_b64_tr_b16 %7, %8 offset:%16\n\ts_waitcnt lgkmcnt(0)"
                 : "=&v"(a0), "=&v"(a1), "=&v"(a2), "=&v"(a3), "=&v"(a4), "=&v"(a5), "=&v"(a6), "=&v"(a7)
                 : "v"(addr), "i"(0 * PITCH), "i"(4 * PITCH), "i"(16 * PITCH), "i"(20 * PITCH), "i"(32 * PITCH), "i"(36 * PITCH), "i"(48 * PITCH), "i"(52 * PITCH) : "memory");
    f[0] = __builtin_shufflevector(a0, a1, 0, 1, 2, 3, 4, 5, 6, 7); f[1] = __builtin_shufflevector(a2, a3, 0, 1, 2, 3, 4, 5, 6, 7);
    f[2] = __builtin_shufflevector(a4, a5, 0, 1, 2, 3, 4, 5, 6, 7); f[3] = __builtin_shufflevector(a6, a7, 0, 1, 2, 3, 4, 5, 6, 7);
}

struct Args { const float* in[24]; float* out; unsigned char* ws; int ph_lo, ph_hi, li, pad; };

__device__ __forceinline__ void p0_transpose_item(const float* W, int pitch, int src_col0, int K, bf16* WT, int dest_row0, LAS float* scr, int kb, int lane) {
    const int k0 = 64 * kb;
#pragma unroll 8
    for (int i = 0; i < 32; ++i) { const int kk = 2 * i + (lane >> 5); scr[kk * 33 + (lane & 31)] = W[(size_t)(k0 + kk) * pitch + src_col0 + (lane & 31)]; }
    LDS_WAIT(); asm volatile("" ::: "memory");
    const int c = lane & 7;
#pragma unroll
    for (int j = 0; j < 4; ++j) { const int n = (lane >> 3) + 8 * j; const LAS float* s = scr + (8 * c) * 33 + n;
        v4u o; o.x = pk2(s[0 * 33], s[1 * 33]); o.y = pk2(s[2 * 33], s[3 * 33]); o.z = pk2(s[4 * 33], s[5 * 33]); o.w = pk2(s[6 * 33], s[7 * 33]);
        *(GAS v4u*)(WT + (size_t)(dest_row0 + n) * K + k0 + 8 * c) = o; }
    LDS_WAIT(); asm volatile("" ::: "memory");
}

constexpr int NPHASES = 16;
#ifndef MK_N_LAUNCHES
#define MK_N_LAUNCHES 1
#endif
constexpr int N_LAUNCHES = MK_N_LAUNCHES;

__global__ void __launch_bounds__(NTHR, 2) fwd_kernel(Args args) {
    extern __shared__ __attribute__((aligned(16))) unsigned char lds[];
    LAS unsigned char* L = (LAS unsigned char*)lds;
    volatile LAS unsigned* MISC = (volatile LAS unsigned*)(L + MISC_OFF);
    const int tid = threadIdx.x, lane = tid & 63, wave = __builtin_amdgcn_readfirstlane(tid >> 6);
    const int G = gridDim.x, bx = blockIdx.x;
    const int vcu = (G % 8 == 0) ? (bx % 8) * (G / 8) + bx / 8 : bx;
    const int gw = vcu * NWAVES + wave, NGW = G * NWAVES;
    unsigned char* ws = args.ws;
    gu32* ctl = (gu32*)(ws + WS_CTL);
    const float* x = args.in[0]; const float* pin = args.in[1]; const float* pre_mix_norm = args.in[2]; const float* w_in = args.in[3];
    const float* a_ln_g = args.in[4]; const float* a_ln_b = args.in[5]; const float* a_sw = args.in[6]; const float* a_sb = args.in[7]; const float* a_out = args.in[8];
    const float* b_gk = args.in[9]; const float* b_gkb = args.in[10]; const float* b_onorm = args.in[11]; const float* b_out = args.in[12]; const float* w_mix = args.in[13];
    const float* post_mix_norm = args.in[14]; const float* pre_ffn_norm = args.in[15]; const float* w_up = args.in[16]; const float* conv_w = args.in[17]; const float* conv_b = args.in[18];
    const float* w_down = args.in[19]; const float* post_ffn_norm = args.in[20]; const float* w_ple = args.in[21]; const float* w_pleg = args.in[22]; const float* post_ple_norm = args.in[23];
    float* out = args.out;
    bf16* Win_t = (bf16*)(ws + WS_WIN); bf16* Aout_t = (bf16*)(ws + WS_AOUT); bf16* Bout_t = (bf16*)(ws + WS_BOUT); bf16* Wmix_t = (bf16*)(ws + WS_WMIX);
    bf16* Wup_t = (bf16*)(ws + WS_WUP); bf16* Wdown_t = (bf16*)(ws + WS_WDOWN); bf16* Wpleg_t = (bf16*)(ws + WS_WPLEG); bf16* Wple_t = (bf16*)(ws + WS_WPLE);
    float* LR = (float*)(ws + WS_LR); bf16* PB = (bf16*)(ws + WS_PB);
    bf16* Ab = (bf16*)out;
    bf16* U = (bf16*)(ws + WS_U); bf16* VA = (bf16*)(ws + WS_VA); bf16* Qb = (bf16*)(ws + WS_Q); bf16* Kb = (bf16*)(ws + WS_K); bf16* VB = (bf16*)(ws + WS_VB);
    bf16* OG = (bf16*)(ws + WS_OG); bf16* GA = (bf16*)(ws + WS_GA); bf16* GB = (bf16*)(ws + WS_GB);
    float* Of = out;
    float* Tf = out;
    bf16* MB = (bf16*)(ws + WS_MB); bf16* Cb = (bf16*)(ws + WS_C); float* MIXED = (float*)(ws + WS_MIXED);
    bf16* RAW = (bf16*)(ws + WS_RAW); bf16* ACT = (bf16*)(ws + WS_ACT); bf16* FB = (bf16*)(ws + WS_FB); bf16* H2B = (bf16*)(ws + WS_H2B);
    float* GS = (float*)(ws + WS_GS); float* PV = (float*)(ws + WS_PV);

    for (int u = tid; u < (LDS_BYTES - LDSCTL_OFF) / 4; u += NTHR) ((LAS unsigned*)(L + LDSCTL_OFF))[u] = 0u;
    __syncthreads();
    XcdBarrier bar; bar.bar = (unsigned*)(ctl + CW_BAR); bar.x = 0; bar.st = nullptr;
    if (N_LAUNCHES == 1) bar = xcd_barrier_post((unsigned*)(ctl + CW_BAR), MISC + 8);
    const int lo = args.ph_lo, hi = args.ph_hi;
#define IN(k) (lo <= (k) && (k) < hi)
#define SEAM(k) do { if (IN(k) && IN((k) + 1)) xcd_barrier(bar); } while (0)

    if (IN(0)) {
        LAS float* scr = (LAS float*)(L + RING_OFF + wave * 16384);
        constexpr int I_IN1 = 16 * 128, I_IN2 = 16 * 64, I_AO = 8 * 32, I_SQ = 16 * 32, I_UP = 16 * 176, I_DN = 44 * 32, I_PL = 4 * 32;
        constexpr int NITEMS = I_IN1 + I_IN2 + I_AO + 3 * I_SQ + I_UP + I_DN + I_PL;
        for (int it = gw; it < NITEMS; it += NGW) {
            int r = it;
            if (r < I_IN1) { const int kb = r / 128, nb = r % 128; p0_transpose_item(w_in, INCOLS, 32 * nb, D, Win_t, 32 * nb, scr, kb, lane); continue; } r -= I_IN1;
            if (r < I_IN2) { const int kb = r / 64, nb = r % 64; p0_transpose_item(w_in, INCOLS, 4112 + 32 * nb, D, Win_t, 4096 + 32 * nb, scr, kb, lane); continue; } r -= I_IN2;
            if (r < I_AO) { const int kb = r / 32, nb = r % 32; p0_transpose_item(a_out, D, 32 * nb, AW, Aout_t, 32 * nb, scr, kb, lane); continue; } r -= I_AO;
            if (r < I_SQ) { const int kb = r / 32, nb = r % 32; p0_transpose_item(b_out, D, 32 * nb, D, Bout_t, 32 * nb, scr, kb, lane); continue; } r -= I_SQ;
            if (r < I_SQ) { const int kb = r / 32, nb = r % 32; p0_transpose_item(w_mix, D, 32 * nb, D, Wmix_t, 32 * nb, scr, kb, lane); continue; } r -= I_SQ;
            if (r < I_SQ) { const int kb = r / 32, nb = r % 32; p0_transpose_item(w_pleg, D, 32 * nb, D, Wpleg_t, 32 * nb, scr, kb, lane); continue; } r -= I_SQ;
            if (r < I_UP) { const int kb = r / 176, nb = r % 176; const int n0 = 32 * nb, j = n0 >> 8, rr = n0 & 255; const int src = (rr < 128) ? (128 * j + rr) : (DFF + 128 * j + (rr - 128));
                p0_transpose_item(w_up, NUP, src, D, Wup_t, n0, scr, kb, lane); continue; } r -= I_UP;
            if (r < I_DN) { const int kb = r / 32, nb = r % 32; p0_transpose_item(w_down, D, 32 * nb, DFF, Wdown_t, 32 * nb, scr, kb, lane); continue; } r -= I_DN;
            { const int kb = r / 32, nb = r % 32; p0_transpose_item(w_ple, D, 32 * nb, PLED, Wple_t, 32 * nb, scr, kb, lane); }
        }
        const size_t NGT = (size_t)G * NTHR;
        for (size_t i = (size_t)vcu * NTHR + tid; i < (size_t)M * PLED / 8; i += NGT) { const f32x4 a = ((const f32x4*)pin)[2 * i], b = ((const f32x4*)pin)[2 * i + 1];
            v4u o; o.x = pk2(a.x, a.y); o.y = pk2(a.z, a.w); o.z = pk2(b.x, b.y); o.w = pk2(b.z, b.w); ((v4u*)PB)[i] = o; }
        { bf16* Wsb = (bf16*)(ws + WS_WSB); for (size_t i = (size_t)vcu * NTHR + tid; i < 8 * 128 * 128; i += NGT) { const int s = (int)(i & 127), t = (int)((i >> 7) & 127); Wsb[i] = (bf16)((s <= t) ? f2bf(a_sw[i]) : 0u); } }
        __syncthreads();
        LAS float* wl = (LAS float*)(L + RING_OFF);
        for (int idx = tid; idx < 1024 * 16; idx += NTHR) { const int i = idx >> 4, c = idx & 15; wl[c * 1024 + i] = w_in[(size_t)i * INCOLS + 4096 + c]; }
        __syncthreads();
        for (int m = gw; m < M; m += NGW) {
            asm volatile("" ::: "memory");
            const f32x4* xr = (const f32x4*)(x + (size_t)m * D) + lane; const f32x4* wn = (const f32x4*)pre_mix_norm + lane;
            f32x4 v[4]; float s = 0.f;
#pragma unroll
            for (int j = 0; j < 4; ++j) { v[j] = xr[64 * j]; s += (v[j].x * v[j].x + v[j].y * v[j].y) + (v[j].z * v[j].z + v[j].w * v[j].w); }
            const float rstd = 1.0f / sqrtf(wave_sum(s) * (1.f / D) + EPS);
            unsigned long long* o8 = (unsigned long long*)(Ab + (size_t)m * D) + lane;
#pragma unroll
            for (int j = 0; j < 4; ++j) { v[j] = v[j] * rstd * wn[64 * j]; o8[64 * j] = (unsigned long long)pk2(v[j].x, v[j].y) | ((unsigned long long)pk2(v[j].z, v[j].w) << 32); }
            float myv = 0.f;
#pragma unroll
            for (int c = 0; c < 16; ++c) { float acc = 0.f;
#pragma unroll
                for (int j = 0; j < 4; ++j) { const f32x4 w4 = *((const LAS f32x4*)(wl + c * 1024) + 64 * j + lane); acc += (v[j].x * w4.x + v[j].y * w4.y) + (v[j].z * w4.z + v[j].w * w4.w); }
                acc = wave_sum(acc); if (lane == c) myv = acc; }
            if (lane < 16) LR[(size_t)m * 16 + lane] = myv;
        }
    }
    SEAM(0);
    if (IN(1)) {
        pg8::Gemm g{Ab, Win_t, M, NINP, D, D}; pg8::StaticOrder S; S.init(M, NINP, G, bx);
        pg8::EpiInProj E{U, VA, Qb, Kb, VB, OG, GA, GB};
        pg8::gemm_phase<pg8::EpiInProj, pg8::StaticOrder, true, true>(L + RING_OFF, g, S, E);
    }
    SEAM(1);
    if (IN(2)) {
        bf16* KVt = (bf16*)out;
        float* DEC = (float*)(ws + WS_DEC);
        const bf16* Wsb = (const bf16*)(ws + WS_WSB);
        const unsigned h5 = lane >> 5, blk = (lane >> 4) & 1, q4l = (lane & 15) >> 2, p4 = lane & 3, r31 = lane & 31;
        const unsigned Lb = (unsigned)(size_t)L;
        for (int it0 = vcu; it0 < 256 + 1024; it0 += G) {
          if (it0 < 256) {
            const int it = it0, hf = it & 1, c = (it >> 1) & 63, b = it >> 7; const size_t r0 = (size_t)b * SEQ + (size_t)c * 128;
            { const int row = tid >> 2, q = tid & 3;
              const v4u* vp = (const v4u*)(VA + (r0 + row) * AW + q * 128); float s1 = 0.f, s2 = 0.f;
#pragma unroll 4
              for (int i = 0; i < 16; ++i) { const v4u w = vp[i];
#pragma unroll
                  for (int e = 0; e < 4; ++e) { const float a = bflo(w[e]), bq = bfhi(w[e]); s1 += a + bq; s2 += a * a + bq * bq; } }
              s1 += __shfl_xor(s1, 1); s2 += __shfl_xor(s2, 1); s1 += __shfl_xor(s1, 2); s2 += __shfl_xor(s2, 2);
              const float mean = s1 * (1.f / AW), var = s2 * (1.f / AW) - mean * mean; const float rstd = 1.0f / sqrtf(fmaxf(var, 0.f) + EPS);
              const int ch0 = (4 * hf + q) * 64;
              const v4u* gp = (const v4u*)(VA + (r0 + row) * AW + ch0);
#pragma unroll
              for (int k8 = 0; k8 < 8; ++k8) { const v4u w = gp[k8]; const f32x4 g0 = *(const f32x4*)(a_ln_g + ch0 + 8 * k8), g1 = *(const f32x4*)(a_ln_g + ch0 + 8 * k8 + 4), b0 = *(const f32x4*)(a_ln_b + ch0 + 8 * k8), b1 = *(const f32x4*)(a_ln_b + ch0 + 8 * k8 + 4);
                  v4u o; o.x = pk2((bflo(w.x) - mean) * rstd * g0.x + b0.x, (bfhi(w.x) - mean) * rstd * g0.y + b0.y); o.y = pk2((bflo(w.y) - mean) * rstd * g0.z + b0.z, (bfhi(w.y) - mean) * rstd * g0.w + b0.w);
                  o.z = pk2((bflo(w.z) - mean) * rstd * g1.x + b1.x, (bfhi(w.z) - mean) * rstd * g1.y + b1.y); o.w = pk2((bflo(w.w) - mean) * rstd * g1.z + b1.z, (bfhi(w.w) - mean) * rstd * g1.w + b1.w);
                  *(LAS v4u*)(L + q * 24576 + row * 192 + k8 * 16) = o; }
            }
            __syncthreads();
            { const int gg = wave >> 1, nt = wave & 1, g = 4 * hf + gg;
              const unsigned vaddr = Lb + (unsigned)(gg * 24576) + (8 * h5 + q4l) * 192 + (4 * nt + 2 * blk + (p4 >> 1)) * 16 + 8 * (p4 & 1);
              bf16x8 vf[8]; { bf16x8 t4[4]; tr_frag4<192>(vaddr, t4); vf[0] = t4[0]; vf[1] = t4[1]; vf[2] = t4[2]; vf[3] = t4[3]; tr_frag4<192>(vaddr + 64 * 192, t4); vf[4] = t4[0]; vf[5] = t4[1]; vf[6] = t4[2]; vf[7] = t4[3]; }
              const bf16* wrow = Wsb + (size_t)g * 16384 + (size_t)r31 * 128 + 8 * h5;
#pragma unroll
              for (int mt = 0; mt < 4; ++mt) { f32x16 acc;
#pragma unroll
                  for (int e = 0; e < 16; ++e) acc[e] = 0.f;
#pragma unroll
                  for (int s = 0; s < 2 * (mt + 1); ++s) { const bf16x8 af = *(const bf16x8*)(wrow + (size_t)(32 * mt) * 128 + 16 * s); acc = __builtin_amdgcn_mfma_f32_32x32x16_bf16(af, vf[s], acc, 0, 0, 0); }
                  const int ch = g * 64 + 32 * nt + r31;
#pragma unroll
                  for (int e = 0; e < 16; ++e) { const int t = 32 * mt + (e & 3) + 8 * (e >> 2) + 4 * h5; bf16* up = U + (r0 + t) * AW + ch;
                      const float sv = acc[e] + a_sb[g * 128 + t]; *up = (bf16)f2bf(bf2f(*up) * sv); } }
            }
            __syncthreads();
          } else {
            const int it = it0 - 256, c = it & 127, h = (it >> 7) & 3, b = it >> 9; const size_t r0 = (size_t)b * SEQ + (size_t)c * 64;
            constexpr int O_LR = 0, O_SEG = 4096, O_QD = 8192, O_KI = 25600, O_KT = 43008, O_VS = 63488, O_PS = 100352;
            const int d = tid & 127, seg = tid >> 7;
            if (tid < 256) *(LAS f32x4*)(L + O_LR + tid * 16) = *(const f32x4*)(LR + r0 * 16 + tid * 4);
#pragma unroll
            for (int k4 = 0; k4 < 4; ++k4) { const int idx = tid + 512 * k4, j = idx >> 5, ch = idx & 31; *(LAS v4u*)(L + O_VS + j * 576 + ch * 16) = *(const v4u*)(VB + (r0 + j) * BVAL + h * 256 + ch * 8); }
            float wg[16];
#pragma unroll
            for (int r = 0; r < 16; ++r) wg[r] = b_gk[r * BKEY + h * 128 + d];
            const float bias = b_gkb[h * 128 + d];
            float qv[16], kv[16];
#pragma unroll
            for (int ii = 0; ii < 16; ++ii) { const size_t off = (r0 + seg * 16 + ii) * BKEY + h * 128 + d; qv[ii] = bf2f(Qb[off]); kv[ii] = bf2f(Kb[off]); }
            __syncthreads();
            float bl[16]; float cum = 0.f;
#pragma unroll
            for (int ii = 0; ii < 16; ++ii) { const LAS f32x4* lp = (const LAS f32x4*)(L + O_LR + (seg * 16 + ii) * 64); float xg = bias;
#pragma unroll
                for (int r4 = 0; r4 < 4; ++r4) { const f32x4 l4 = lp[r4]; xg += l4.x * wg[4 * r4] + l4.y * wg[4 * r4 + 1] + l4.z * wg[4 * r4 + 2] + l4.w * wg[4 * r4 + 3]; }
                const float ls = fminf(xg, 0.f) - log1pf(__expf(-fabsf(xg))); cum += ls * (1.f / 16.f); bl[ii] = cum; }
            ((LAS float*)(L + O_SEG))[seg * 128 + d] = cum;
            __syncthreads();
            float pre = 0.f, tot = 0.f;
#pragma unroll
            for (int s = 0; s < 4; ++s) { const float sv = ((const LAS float*)(L + O_SEG))[s * 128 + d]; tot += sv; if (s < seg) pre += sv; }
#pragma unroll
            for (int ii = 0; ii < 16; ++ii) { const int i = seg * 16 + ii; const float bv = bl[ii] + pre; const float qd = qv[ii] * __expf(bv), ki = kv[ii] * __expf(-bv), kt = kv[ii] * __expf(tot - bv);
                const bf16 qdb = (bf16)f2bf(qd);
                *(LAS bf16*)(L + O_QD + i * 272 + d * 2) = qdb; *(LAS bf16*)(L + O_KI + i * 272 + d * 2) = (bf16)f2bf(ki); *(LAS bf16*)(L + O_KT + i * 320 + d * 2) = (bf16)f2bf(kt);
                Qb[(r0 + i) * BKEY + h * 128 + d] = qdb; }
            if (seg == 0) DEC[(size_t)it * 128 + d] = __expf(tot);
            __syncthreads();
            if (wave < 3) {
                const int mt = wave > 0, nt = wave > 1; f32x16 acc;
#pragma unroll
                for (int e = 0; e < 16; ++e) acc[e] = 0.f;
#pragma unroll
                for (int s = 0; s < 8; ++s) { const bf16x8 af = *(const LAS bf16x8*)(L + O_QD + (32 * mt + r31) * 272 + (2 * s + h5) * 16), bfr = *(const LAS bf16x8*)(L + O_KI + (32 * nt + r31) * 272 + (2 * s + h5) * 16);
                    acc = __builtin_amdgcn_mfma_f32_32x32x16_bf16(af, bfr, acc, 0, 0, 0); }
#pragma unroll
                for (int e = 0; e < 16; ++e) { const int i = 32 * mt + (e & 3) + 8 * (e >> 2) + 4 * h5, j = 32 * nt + r31; *(LAS bf16*)(L + O_PS + i * 144 + j * 2) = (bf16)f2bf(j <= i ? acc[e] : 0.f); }
            }
            __syncthreads();
            {
                bf16x8 vf[4]; tr_frag4<576>(Lb + (unsigned)O_VS + (8 * h5 + q4l) * 576 + (4 * wave + 2 * blk + (p4 >> 1)) * 16 + 8 * (p4 & 1), vf);
                const unsigned kaddr = Lb + (unsigned)O_KT + (8 * h5 + q4l) * 320 + (2 * blk + (p4 >> 1)) * 16 + 8 * (p4 & 1);
                bf16* kvp = KVt + (size_t)it * 32768 + (size_t)(32 * wave + r31) * 128;
#pragma unroll
                for (int mt = 0; mt < 4; ++mt) { bf16x8 kf[4]; tr_frag4<320>(kaddr + 64 * mt, kf); f32x16 acc;
#pragma unroll
                    for (int e = 0; e < 16; ++e) acc[e] = 0.f;
#pragma unroll
                    for (int ks = 0; ks < 4; ++ks) acc = __builtin_amdgcn_mfma_f32_32x32x16_bf16(kf[ks], vf[ks], acc, 0, 0, 0);
#pragma unroll
                    for (int g4 = 0; g4 < 4; ++g4) { uint2 o; o.x = pk2(acc[4 * g4], acc[4 * g4 + 1]); o.y = pk2(acc[4 * g4 + 2], acc[4 * g4 + 3]); *(uint2*)(kvp + 32 * mt + 8 * g4 + 4 * h5) = o; } }
#pragma unroll
                for (int mt = 0; mt < 2; ++mt) { f32x16 acc;
#pragma unroll
                    for (int e = 0; e < 16; ++e) acc[e] = 0.f;
#pragma unroll
                    for (int ks = 0; ks < 2 * (mt + 1); ++ks) { const bf16x8 pf = *(const LAS bf16x8*)(L + O_PS + (32 * mt + r31) * 144 + (2 * ks + h5) * 16); acc = __builtin_amdgcn_mfma_f32_32x32x16_bf16(pf, vf[ks], acc, 0, 0, 0); }
#pragma unroll
                    for (int e = 0; e < 16; ++e) { const int i = 32 * mt + (e & 3) + 8 * (e >> 2) + 4 * h5; VB[(r0 + i) * BVAL + h * 256 + 32 * wave + r31] = (bf16)f2bf(acc[e]); } }
            }
            __syncthreads();
          }
        }
    }
    SEAM(2);
    if (IN(3)) {
        bf16* KVt = (bf16*)out; const float* DEC = (const float*)(ws + WS_DEC);
        for (int gi = vcu * NTHR + tid; gi < 8 * 16384; gi += G * NTHR) {
            const int bh = gi >> 14, pi = gi & 16383, d = (2 * pi) & 127;
            unsigned* p = (unsigned*)(KVt + (size_t)bh * 128 * 32768 + 2 * pi); const float* dp = DEC + (size_t)bh * 128 * 128 + d;
            float s0 = 0.f, s1 = 0.f;
            for (int c0 = 0; c0 < 128; c0 += 8) { unsigned kvw[8]; float2 dc[8];
#pragma unroll
                for (int u = 0; u < 8; ++u) { kvw[u] = p[(size_t)(c0 + u) * 16384]; dc[u] = *(const float2*)(dp + (c0 + u) * 128); }
#pragma unroll
                for (int u = 0; u < 8; ++u) { p[(size_t)(c0 + u) * 16384] = pk2(s0, s1); s0 = dc[u].x * s0 + bflo(kvw[u]); s1 = dc[u].y * s1 + bfhi(kvw[u]); } }
        }
    }
    SEAM(3);
    if (IN(4)) {
        const bf16* KVt = (const bf16*)out;
        const unsigned h5 = lane >> 5, r31 = lane & 31;
        constexpr int O_QD = 0, O_OS = 17408;
        for (int it = vcu; it < 1024; it += G) {
            const int c = it & 127, h = (it >> 7) & 3, b = it >> 9; const size_t r0 = (size_t)b * SEQ + (size_t)c * 64;
#pragma unroll
            for (int k2 = 0; k2 < 2; ++k2) { const int idx = tid + 512 * k2, row = idx >> 4, ch = idx & 15; *(LAS v4u*)(L + O_QD + row * 272 + ch * 16) = *(const v4u*)(Qb + (r0 + row) * BKEY + h * 128 + ch * 8); }
            __syncthreads();
            f32x16 acc[2];
#pragma unroll
            for (int mt = 0; mt < 2; ++mt)
#pragma unroll
                for (int e = 0; e < 16; ++e) acc[mt][e] = 0.f;
            if (c > 0) { const bf16* sp = KVt + (size_t)it * 32768 + (size_t)(32 * wave + r31) * 128 + 8 * h5;
#pragma unroll
                for (int s = 0; s < 8; ++s) { const bf16x8 bfr = *(const bf16x8*)(sp + 16 * s);
#pragma unroll
                    for (int mt = 0; mt < 2; ++mt) { const bf16x8 af = *(const LAS bf16x8*)(L + O_QD + (32 * mt + r31) * 272 + (2 * s + h5) * 16); acc[mt] = __builtin_amdgcn_mfma_f32_32x32x16_bf16(af, bfr, acc[mt], 0, 0, 0); } } }
#pragma unroll
            for (int mt = 0; mt < 2; ++mt)
#pragma unroll
                for (int e = 0; e < 16; ++e) { const int i = 32 * mt + (e & 3) + 8 * (e >> 2) + 4 * h5; const int dv = 32 * wave + r31;
                    ((LAS float*)(L + O_OS))[i * 260 + dv] = acc[mt][e] + bf2f(VB[(r0 + i) * BVAL + h * 256 + dv]); }
            __syncthreads();
            const f32x4 wn = ((const f32x4*)b_onorm)[lane];
#pragma unroll
            for (int ri = 0; ri < 8; ++ri) { const int i = 8 * wave + ri; const f32x4 v = *(const LAS f32x4*)(L + O_OS + (i * 260 + 4 * lane) * 4);
                const float ss = wave_sum((v.x * v.x + v.y * v.y) + (v.z * v.z + v.w * v.w)); const float rstd = 1.0f / sqrtf(ss * (1.f / 256.f) + EPS);
                const size_t off = (r0 + i) * BVAL + h * 256 + 4 * lane; const uint2 gg = *(const uint2*)(OG + off);
                uint2 o; o.x = pk2(v.x * rstd * wn.x * bflo(gg.x), v.y * rstd * wn.y * bfhi(gg.x)); o.y = pk2(v.z * rstd * wn.z * bflo(gg.y), v.w * rstd * wn.w * bfhi(gg.y)); *(uint2*)(VB + off) = o; }
            __syncthreads();
        }
    }
    SEAM(4);
    if (IN(5)) {
        { pg8::Gemm g{U, Aout_t, M, D, AW, AW}; pg8::StaticOrder S; S.init(M, D, G, bx); pg8::EpiGateMul E{GA, Tf, D};
          pg8::gemm_phase<pg8::EpiGateMul, pg8::StaticOrder, true, true>(L + RING_OFF, g, S, E); }
        { pg8::Gemm g{VB, Bout_t, M, D, D, D}; pg8::StaticOrder S; S.init(M, D, G, bx); pg8::EpiGateMulAdd E{GB, Tf, MB, D};
          pg8::gemm_phase<pg8::EpiGateMulAdd, pg8::StaticOrder, true, true>(L + RING_OFF, g, S, E); }
    }
    SEAM(5);
    if (IN(6)) {
        pg8::Gemm g{MB, Wmix_t, M, D, D, D}; pg8::StaticOrder S; S.init(M, D, G, bx); pg8::EpiF32 E{MIXED, D};
        pg8::gemm_phase<pg8::EpiF32, pg8::StaticOrder, true, true>(L + RING_OFF, g, S, E);
    }
    SEAM(6);
    if (IN(7)) {
        for (int m = gw; m < M; m += NGW) {
            const f32x4* mr = (const f32x4*)(MIXED + (size_t)m * D) + lane; const f32x4* xr = (const f32x4*)(x + (size_t)m * D) + lane;
            f32x4 v[4]; float s = 0.f;
#pragma unroll
            for (int j = 0; j < 4; ++j) { v[j] = mr[64 * j]; s += (v[j].x * v[j].x + v[j].y * v[j].y) + (v[j].z * v[j].z + v[j].w * v[j].w); }
            const float rstd = 1.0f / sqrtf(wave_sum(s) * (1.f / D) + EPS); float s2 = 0.f;
            f32x4* orow = (f32x4*)(out + (size_t)m * D) + lane;
#pragma unroll
            for (int j = 0; j < 4; ++j) { v[j] = xr[64 * j] + v[j] * rstd * ((const f32x4*)post_mix_norm)[64 * j + lane]; orow[64 * j] = v[j]; s2 += (v[j].x * v[j].x + v[j].y * v[j].y) + (v[j].z * v[j].z + v[j].w * v[j].w); }
            const float rstd2 = 1.0f / sqrtf(wave_sum(s2) * (1.f / D) + EPS);
            unsigned long long* o8 = (unsigned long long*)(Cb + (size_t)m * D) + lane;
#pragma unroll
            for (int j = 0; j < 4; ++j) { const f32x4 c4 = v[j] * rstd2 * ((const f32x4*)pre_ffn_norm)[64 * j + lane]; o8[64 * j] = (unsigned long long)pk2(c4.x, c4.y) | ((unsigned long long)pk2(c4.z, c4.w) << 32); }
        }
    }
    SEAM(7);
#pragma unroll 1
    for (int half = 0; half < 2; ++half) {
        if (IN(8 + 2 * half)) {
            pg8::Gemm g{Cb, Wup_t + (size_t)half * NHALF * D, M, NHALF, D, D}; pg8::StaticOrder S; S.init(M, NHALF, G, bx); pg8::EpiPlain E{RAW, NHALF};
            pg8::gemm_phase<pg8::EpiPlain, pg8::StaticOrder, true, true>(L + RING_OFF, g, S, E);
        }
        SEAM(8 + 2 * half);
        if (IN(9 + 2 * half)) {
            const size_t NGT = (size_t)G * NTHR;
            for (size_t i = (size_t)vcu * NTHR + tid; i < (size_t)M * 176; i += NGT) {
                const int oct = (int)(i % 176); const size_t row = i / 176; const int tl = (int)(row & (SEQ - 1));
                const int cl = oct * 8, j = cl >> 7, r = cl & 127; const int ch = half * 1408 + cl;
                const bf16* rp = RAW + row * NHALF + 256 * j + r;
                float yg[8], yv[8];
                { const f32x4 b0 = *(const f32x4*)(conv_b + ch), b1 = *(const f32x4*)(conv_b + ch + 4), c0 = *(const f32x4*)(conv_b + DFF + ch), c1 = *(const f32x4*)(conv_b + DFF + ch + 4);
                  yg[0] = b0.x; yg[1] = b0.y; yg[2] = b0.z; yg[3] = b0.w; yg[4] = b1.x; yg[5] = b1.y; yg[6] = b1.z; yg[7] = b1.w;
                  yv[0] = c0.x; yv[1] = c0.y; yv[2] = c0.z; yv[3] = c0.w; yv[4] = c1.x; yv[5] = c1.y; yv[6] = c1.z; yv[7] = c1.w; }
#pragma unroll
                for (int tap = 0; tap < 3; ++tap) { const int back = 2 - tap; if (tl >= back) {
                    const v4u wg4 = *(const v4u*)(rp - (size_t)back * NHALF), wv4 = *(const v4u*)(rp - (size_t)back * NHALF + 128);
                    const float* cwg = conv_w + (size_t)tap * NUP + ch; const float* cwv = conv_w + (size_t)tap * NUP + DFF + ch;
#pragma unroll
                    for (int e = 0; e < 4; ++e) { yg[2 * e] += cwg[2 * e] * bflo(wg4[e]); yg[2 * e + 1] += cwg[2 * e + 1] * bfhi(wg4[e]); yv[2 * e] += cwv[2 * e] * bflo(wv4[e]); yv[2 * e + 1] += cwv[2 * e + 1] * bfhi(wv4[e]); } } }
                v4u o;
#pragma unroll
                for (int e = 0; e < 4; ++e) o[e] = pk2(gelu_t(yg[2 * e]) * yv[2 * e], gelu_t(yg[2 * e + 1]) * yv[2 * e + 1]);
                *(v4u*)(ACT + row * DFF + ch) = o;
            }
        }
        SEAM(9 + 2 * half);
    }
    if (IN(12)) {
        pg8::Gemm g{ACT, Wdown_t, M, D, DFF, DFF}; pg8::StaticOrder S; S.init(M, D, G, bx); pg8::EpiPlain E{FB, D};
        pg8::gemm_phase<pg8::EpiPlain, pg8::StaticOrder, true, true>(L + RING_OFF, g, S, E);
    }
    SEAM(12);
    if (IN(13)) {
        for (int m = gw; m < M; m += NGW) {
            const uint2* fr2 = (const uint2*)(FB + (size_t)m * D) + lane; f32x4* orow = (f32x4*)(out + (size_t)m * D) + lane;
            f32x4 v[4]; float s = 0.f;
#pragma unroll
            for (int j = 0; j < 4; ++j) { const uint2 w = fr2[64 * j]; v[j] = (f32x4){bflo(w.x), bfhi(w.x), bflo(w.y), bfhi(w.y)}; s += (v[j].x * v[j].x + v[j].y * v[j].y) + (v[j].z * v[j].z + v[j].w * v[j].w); }
            const float rstd = 1.0f / sqrtf(wave_sum(s) * (1.f / D) + EPS);
            unsigned long long* o8 = (unsigned long long*)(H2B + (size_t)m * D) + lane;
#pragma unroll
            for (int j = 0; j < 4; ++j) { const f32x4 h = orow[64 * j] + v[j] * rstd * ((const f32x4*)post_ffn_norm)[64 * j + lane]; orow[64 * j] = h; o8[64 * j] = (unsigned long long)pk2(h.x, h.y) | ((unsigned long long)pk2(h.z, h.w) << 32); }
        }
    }
    SEAM(13);
    if (IN(14)) {
        { pg8::Gemm g{H2B, Wpleg_t, M, D, D, D}; pg8::StaticOrder S; S.init(M, D, G, bx); pg8::EpiF32 E{GS, D};
          pg8::gemm_phase<pg8::EpiF32, pg8::StaticOrder, true, true>(L + RING_OFF, g, S, E); }
        { pg8::Gemm g{PB, Wple_t, M, D, PLED, PLED}; pg8::StaticOrder S; S.init(M, D, G, bx); pg8::EpiF32 E{PV, D};
          pg8::gemm_phase<pg8::EpiF32, pg8::StaticOrder, true, true>(L + RING_OFF, g, S, E); }
    }
    SEAM(14);
    if (IN(15)) {
        for (int m = gw; m < M; m += NGW) {
            const f32x4* gr = (const f32x4*)(GS + (size_t)m * D) + lane; const f32x4* pr = (const f32x4*)(PV + (size_t)m * D) + lane; f32x4* orow = (f32x4*)(out + (size_t)m * D) + lane;
            f32x4 v[4]; float s = 0.f;
#pragma unroll
            for (int j = 0; j < 4; ++j) { const f32x4 g4 = gr[64 * j], p4 = pr[64 * j]; v[j] = (f32x4){sigm(g4.x) * p4.x, sigm(g4.y) * p4.y, sigm(g4.z) * p4.z, sigm(g4.w) * p4.w}; s += (v[j].x * v[j].x + v[j].y * v[j].y) + (v[j].z * v[j].z + v[j].w * v[j].w); }
            const float rstd = 1.0f / sqrtf(wave_sum(s) * (1.f / D) + EPS);
#pragma unroll
            for (int j = 0; j < 4; ++j) orow[64 * j] = orow[64 * j] + v[j] * rstd * ((const f32x4*)post_ple_norm)[64 * j + lane];
        }
    }
#undef IN
#undef SEAM
}

extern "C" void kernel_launch(void* const* d_in, const int* in_sizes, int n_in, void* d_out, int out_size, void* d_ws, size_t ws_size, hipStream_t stream) {
    static int grid = 0;
    if (grid == 0) {
        if (n_in != 24 || in_sizes[0] != M * D || out_size != M * D || ws_size < WS_END) { fprintf(stderr, "kernel_launch: unexpected shapes (n_in %d in0 %d out %d ws %zu)\n", n_in, n_in > 0 ? in_sizes[0] : -1, out_size, ws_size); grid = -1; return; }
        int dev = 0, cus = 0, per_cu = 0;
        if (hipGetDevice(&dev) != hipSuccess || hipDeviceGetAttribute(&cus, hipDeviceAttributeMultiprocessorCount, dev) != hipSuccess) { grid = -1; return; }
        if (hipFuncSetAttribute((const void*)fwd_kernel, hipFuncAttributeMaxDynamicSharedMemorySize, LDS_BYTES) != hipSuccess) { fprintf(stderr, "kernel_launch: hipFuncSetAttribute failed\n"); grid = -1; return; }
        if (hipOccupancyMaxActiveBlocksPerMultiprocessor(&per_cu, (const void*)fwd_kernel, NTHR, LDS_BYTES) != hipSuccess || per_cu < 1) fprintf(stderr, "kernel_launch: occupancy query says %d per CU\n", per_cu);
        (void)hipGetLastError();
        grid = cus;
    }
    if (grid < 0) return;
    (void)hipMemsetAsync((char*)d_ws + WS_CTL, 0, CTL_ZERO_BYTES, stream);
    Args a{};
    for (int i = 0; i < 24; ++i) a.in[i] = (const float*)d_in[i];
    a.out = (float*)d_out; a.ws = (unsigned char*)d_ws;
    if (N_LAUNCHES == 1) { a.ph_lo = 0; a.ph_hi = NPHASES; a.li = 0; hipLaunchKernelGGL(fwd_kernel, dim3(grid), dim3(NTHR), LDS_BYTES, stream, a); }
    else for (int li = 0; li < NPHASES; ++li) { a.ph_lo = li; a.ph_hi = li + 1; a.li = li; hipLaunchKernelGGL(fwd_kernel, dim3(grid), dim3(NTHR), LDS_BYTES, stream, a); }
}
```
